# Optimizing an MI355X kernel written in HIP

```python
import jax, jax.numpy as jnp
from jax import lax
import numpy as np


D_MODEL = 2048
BATCH = 4
SEQ = 2048
DEPTH = 1

MEM_LEN = 256
HEAD_DIM = 128
NSA_HEADS = 8
NSA_KV_HEADS = 2
NSA_GROUP = NSA_HEADS // NSA_KV_HEADS
NSA_WIDTH = NSA_HEADS * HEAD_DIM
KV_WIDTH = NSA_KV_HEADS * HEAD_DIM
N_BRANCH = 3
CONV_WIDTH = D_MODEL - NSA_WIDTH
CONV_KERNEL = 31
CMP_LEN = 32
CMP_STRIDE = 16
SEL_BLK = 64
N_SEL = 16
WINDOW = 512
Q_BLOCK = 128
SEL_Q_CHUNK = 64
MEM_HEADS = 4
MEM_WIDTH = MEM_HEADS * HEAD_DIM
FFN_HIDDEN = -(-8 * D_MODEL // (3 * 256)) * 256
IN_SIZES = (NSA_WIDTH, KV_WIDTH, KV_WIDTH, KV_WIDTH, KV_WIDTH, KV_WIDTH, KV_WIDTH, N_BRANCH * NSA_HEADS, 2 * CONV_WIDTH)
IN_WIDTH = sum(IN_SIZES)
NEG_INF = -1e30
FORCE_BONUS = 1e3

kernel_name = 'hymba_nsa_conformer_hybrid_block'


def rms_norm(x, g, eps=1e-6):
    xf = x.astype(jnp.float32)
    y = xf * lax.rsqrt(jnp.mean(xf * xf, axis=-1, keepdims=True) + eps)
    return (y * g.astype(jnp.float32)).astype(x.dtype)


def layer_norm(x, g, b, eps=1e-5):
    xf = x.astype(jnp.float32)
    mu = jnp.mean(xf, axis=-1, keepdims=True)
    var = jnp.mean(jnp.square(xf - mu), axis=-1, keepdims=True)
    y = (xf - mu) * lax.rsqrt(var + eps) * g.astype(jnp.float32) + b.astype(jnp.float32)
    return y.astype(x.dtype)


def masked_softmax(s, mask, axis=-1):
    p = jax.nn.softmax(jnp.where(mask, s, NEG_INF), axis=axis)
    return p * mask


def alibi_slopes(n):
    return jnp.exp2(-8.0 * (jnp.arange(n, dtype=jnp.float32) + 1.0) / n)


def compress(kv, pos_emb, w1, w2):
    B, T, G, dh = kv.shape
    n_cmp = (T - CMP_LEN) // CMP_STRIDE + 1
    idx = jnp.arange(n_cmp)[:, None] * CMP_STRIDE + jnp.arange(CMP_LEN)[None, :]
    blocks = kv[:, idx] + pos_emb[:, None, :]
    blocks = blocks.transpose(0, 1, 3, 2, 4).reshape(B, n_cmp, G, CMP_LEN * dh)
    return jax.nn.silu(blocks @ w1) @ w2


def compressed_attention(q, k, v, slopes):
    B, T, G, Hg, dh = q.shape
    n_cmp = k.shape[1]
    s = jnp.einsum('btghd,bcgd->bghtc', q, k).astype(jnp.float32) * dh ** -0.5
    t = jnp.arange(T)
    start = jnp.arange(n_cmp) * CMP_STRIDE
    mid = start.astype(jnp.float32) + (CMP_LEN - 1) / 2.0
    dist = t[:, None].astype(jnp.float32) - mid[None, :]
    mask = (start[None, :] + CMP_LEN - 1) <= t[:, None]
    s = s - slopes[None, :, :, None, None] * dist
    p = masked_softmax(s, mask)
    o = jnp.einsum('bghtc,bcgd->btghd', p.astype(v.dtype), v)
    return o, p


def select_blocks(p_cmp, T):
    n_cmp = p_cmp.shape[-1]
    n_blk = T // SEL_BLK
    n_sel = min(N_SEL, n_blk)
    cs = jnp.arange(n_cmp)[:, None] * CMP_STRIDE
    bs = jnp.arange(n_blk)[None, :] * SEL_BLK
    overlap = jnp.clip(jnp.minimum(cs + CMP_LEN, bs + SEL_BLK) - jnp.maximum(cs, bs), 0, None).astype(jnp.float32) / CMP_LEN
    imp = jnp.einsum('bghtc,cs->bgts', p_cmp, overlap)
    t = jnp.arange(T)[:, None]
    blk = jnp.arange(n_blk)[None, :]
    cur = t // SEL_BLK
    valid = blk * SEL_BLK <= t
    forced = (blk == 0) | (blk == cur) | (blk == cur - 1)
    score = jnp.where(valid, imp + FORCE_BONUS * forced, NEG_INF)
    _, idx = lax.top_k(score, n_sel)
    return idx


def selected_attention(q, k, v, idx, slopes):
    B, T, G, Hg, dh = q.shape
    n_blk = T // SEL_BLK
    n_sel = idx.shape[-1]
    n_ch = T // SEL_Q_CHUNK
    kb = k.reshape(B, n_blk, SEL_BLK, G, dh).transpose(0, 3, 1, 2, 4)
    vb = v.reshape(B, n_blk, SEL_BLK, G, dh).transpose(0, 3, 1, 2, 4)
    q_ch = q.reshape(B, n_ch, SEL_Q_CHUNK, G, Hg, dh).transpose(1, 0, 2, 3, 4, 5)
    i_ch = idx.reshape(B, G, n_ch, SEL_Q_CHUNK, n_sel).transpose(2, 0, 1, 3, 4)
    t_ch = jnp.arange(T).reshape(n_ch, SEL_Q_CHUNK)
    bi = jnp.arange(B)[:, None, None, None]
    gi = jnp.arange(G)[None, :, None, None]
    offs = jnp.arange(SEL_BLK)

    def chunk(args):
        qc, ic, tc = args
        ks = kb[bi, gi, ic]
        vs = vb[bi, gi, ic]
        s = jnp.einsum('bqghd,bgqnkd->bghqnk', qc, ks).astype(jnp.float32) * dh ** -0.5
        pos = ic[..., None] * SEL_BLK + offs
        dist = (tc[:, None, None] - pos)[:, :, None]
        s = s - slopes[None, :, :, None, None, None] * dist.astype(jnp.float32)
        p = masked_softmax(s, dist >= 0, axis=(-2, -1))
        return jnp.einsum('bghqnk,bgqnkd->bqghd', p.astype(vs.dtype), vs)

    o = lax.map(chunk, (q_ch, i_ch, t_ch))
    return o.transpose(1, 0, 2, 3, 4, 5).reshape(B, T, G, Hg, dh)


def window_attention(q, k, v, slopes):
    B, T, G, Hg, dh = q.shape
    nb = T // Q_BLOCK
    span = WINDOW + Q_BLOCK
    pad = ((0, 0), (WINDOW, 0), (0, 0), (0, 0))
    kp = jnp.pad(k, pad)
    vp = jnp.pad(v, pad)
    idx = jnp.arange(nb)[:, None] * Q_BLOCK + jnp.arange(span)[None, :]
    kw = kp[:, idx]
    vw = vp[:, idx]
    qb = q.reshape(B, nb, Q_BLOCK, G, Hg, dh)
    s = jnp.einsum('bnqghd,bnkgd->bnghqk', qb, kw).astype(jnp.float32) * dh ** -0.5
    t = jnp.arange(nb)[:, None] * Q_BLOCK + jnp.arange(Q_BLOCK)[None, :]
    spos = idx - WINDOW
    dist = t[:, :, None] - spos[:, None, :]
    mask = (dist >= 0) & (dist < WINDOW) & (spos[:, None, :] >= 0)
    s = s - slopes[None, None, :, :, None, None] * dist[None, :, None, None].astype(jnp.float32)
    p = masked_softmax(s, mask[None, :, None, None])
    o = jnp.einsum('bnghqk,bnkgd->bnqghd', p.astype(vw.dtype), vw)
    return o.reshape(B, T, G, Hg, dh)


def conformer_conv(u, conv_w, conv_b, ln_g, ln_b):
    a, b = jnp.split(u, 2, axis=-1)
    h = a * jax.nn.sigmoid(b)
    C = h.shape[-1]
    h = lax.conv_general_dilated(h, conv_w[:, None, :].astype(h.dtype), (1,), [(CONV_KERNEL - 1, 0)],
                                 dimension_numbers=('NWC', 'WIO', 'NWC'), feature_group_count=C) + conv_b
    return jax.nn.silu(layer_norm(h, ln_g, ln_b))


def memory_cross_attention(hq, hm, w_mq, w_mk, w_mv, mq_norm, mk_norm, w_mo):
    B, T, _ = hq.shape
    M = hm.shape[1]
    q = rms_norm((hq @ w_mq).reshape(B, T, MEM_HEADS, HEAD_DIM), mq_norm)
    k = rms_norm((hm @ w_mk).reshape(B, M, MEM_HEADS, HEAD_DIM), mk_norm)
    v = (hm @ w_mv).reshape(B, M, MEM_HEADS, HEAD_DIM)
    s = jnp.einsum('bthd,bmhd->bhtm', q, k).astype(jnp.float32) * HEAD_DIM ** -0.5
    p = jax.nn.softmax(s, axis=-1)
    o = jnp.einsum('bhtm,bmhd->bthd', p.astype(v.dtype), v).reshape(B, T, MEM_WIDTH)
    return o @ w_mo


def swiglu(h, w_gate, w_up, w_down):
    return (jax.nn.silu(h @ w_gate) * (h @ w_up)) @ w_down


def setup_inputs(seed: int = 0) -> dict:
    key = jax.random.key(seed)
    ks = jax.random.split(key, 40)
    f32 = jnp.float32

    def nrm(k, shape, scale):
        return jax.random.normal(k, shape, f32) * scale

    def gain(k, n):
        return 1.0 + 0.01 * jax.random.normal(k, (DEPTH, n), f32)

    L, dh = DEPTH, HEAD_DIM
    return {
        'x': nrm(ks[0], (BATCH, SEQ, D_MODEL), 1.0),
        'mem': nrm(ks[1], (BATCH, MEM_LEN, D_MODEL), 1.0),
        'norm_mix': gain(ks[2], D_MODEL),
        'w_in': nrm(ks[3], (L, D_MODEL, IN_WIDTH), D_MODEL ** -0.5),
        'gate_b': nrm(ks[4], (L, N_BRANCH * NSA_HEADS), 0.01),
        'q_norm': gain(ks[5], dh),
        'k_norm_cmp': gain(ks[6], dh),
        'k_norm_slc': gain(ks[7], dh),
        'k_norm_win': gain(ks[8], dh),
        'cmp_pos_k': nrm(ks[9], (L, CMP_LEN, dh), 0.1),
        'cmp_pos_v': nrm(ks[10], (L, CMP_LEN, dh), 0.1),
        'cmp_k_w1': nrm(ks[11], (L, CMP_LEN * dh, dh), (CMP_LEN * dh) ** -0.5),
        'cmp_k_w2': nrm(ks[12], (L, dh, dh), dh ** -0.5),
        'cmp_v_w1': nrm(ks[13], (L, CMP_LEN * dh, dh), (CMP_LEN * dh) ** -0.5),
        'cmp_v_w2': nrm(ks[14], (L, dh, dh), dh ** -0.5),
        'conv_w': nrm(ks[15], (L, CONV_KERNEL, CONV_WIDTH), CONV_KERNEL ** -0.5),
        'conv_b': nrm(ks[16], (L, CONV_WIDTH), 0.01),
        'conv_ln_g': gain(ks[17], CONV_WIDTH),
        'conv_ln_b': nrm(ks[18], (L, CONV_WIDTH), 0.01),
        'w_out': nrm(ks[19], (L, NSA_WIDTH + CONV_WIDTH, D_MODEL), (NSA_WIDTH + CONV_WIDTH) ** -0.5),
        'norm_mem_q': gain(ks[20], D_MODEL),
        'norm_mem_kv': gain(ks[21], D_MODEL),
        'w_mq': nrm(ks[22], (L, D_MODEL, MEM_WIDTH), D_MODEL ** -0.5),
        'w_mk': nrm(ks[23], (L, D_MODEL, MEM_WIDTH), D_MODEL ** -0.5),
        'w_mv': nrm(ks[24], (L, D_MODEL, MEM_WIDTH), D_MODEL ** -0.5),
        'mq_norm': gain(ks[25], dh),
        'mk_norm': gain(ks[26], dh),
        'w_mo': nrm(ks[27], (L, MEM_WIDTH, D_MODEL), MEM_WIDTH ** -0.5),
        'norm_ffn': gain(ks[28], D_MODEL),
        'w_gate': nrm(ks[29], (L, D_MODEL, FFN_HIDDEN), D_MODEL ** -0.5),
        'w_up': nrm(ks[30], (L, D_MODEL, FFN_HIDDEN), D_MODEL ** -0.5),
        'w_down': nrm(ks[31], (L, FFN_HIDDEN, D_MODEL), FFN_HIDDEN ** -0.5),
    }


def reference(x, mem, norm_mix, w_in, gate_b, q_norm, k_norm_cmp, k_norm_slc, k_norm_win,
              cmp_pos_k, cmp_pos_v, cmp_k_w1, cmp_k_w2, cmp_v_w1, cmp_v_w2,
              conv_w, conv_b, conv_ln_g, conv_ln_b, w_out,
              norm_mem_q, norm_mem_kv, w_mq, w_mk, w_mv, mq_norm, mk_norm, w_mo,
              norm_ffn, w_gate, w_up, w_down):
    B, T, _ = x.shape
    G, Hg, dh = NSA_KV_HEADS, NSA_GROUP, HEAD_DIM
    slopes = alibi_slopes(NSA_HEADS).reshape(G, Hg)
    splits = np.cumsum(IN_SIZES)[:-1].tolist()
    for l in range(DEPTH):
        h = rms_norm(x, norm_mix[l])
        z = h @ w_in[l]
        q, kc, vc, ksl, vsl, kw, vw, g, u = jnp.split(z, splits, axis=-1)
        q = rms_norm(q.reshape(B, T, NSA_HEADS, dh), q_norm[l]).reshape(B, T, G, Hg, dh)
        kv_shape = (B, T, G, dh)
        k_cmp = rms_norm(compress(kc.reshape(kv_shape), cmp_pos_k[l], cmp_k_w1[l], cmp_k_w2[l]), k_norm_cmp[l])
        v_cmp = compress(vc.reshape(kv_shape), cmp_pos_v[l], cmp_v_w1[l], cmp_v_w2[l])
        o_cmp, p_cmp = compressed_attention(q, k_cmp, v_cmp, slopes)
        sel_idx = select_blocks(p_cmp, T)
        o_slc = selected_attention(q, rms_norm(ksl.reshape(kv_shape), k_norm_slc[l]), vsl.reshape(kv_shape), sel_idx, slopes)
        o_win = window_attention(q, rms_norm(kw.reshape(kv_shape), k_norm_win[l]), vw.reshape(kv_shape), slopes)
        gates = jax.nn.sigmoid(g + gate_b[l]).reshape(B, T, G, Hg, N_BRANCH)
        o_nsa = (gates[..., 0:1] * o_cmp + gates[..., 1:2] * o_slc + gates[..., 2:3] * o_win).reshape(B, T, NSA_WIDTH)
        o_conv = conformer_conv(u, conv_w[l], conv_b[l], conv_ln_g[l], conv_ln_b[l])
        x = x + jnp.concatenate([o_nsa, o_conv], axis=-1) @ w_out[l]
        x = x + memory_cross_attention(rms_norm(x, norm_mem_q[l]), rms_norm(mem, norm_mem_kv[l]),
                                       w_mq[l], w_mk[l], w_mv[l], mq_norm[l], mk_norm[l], w_mo[l])
        x = x + swiglu(rms_norm(x, norm_ffn[l]), w_gate[l], w_up[l], w_down[l])
    return x
```

```cpp
#include <hip/hip_runtime.h>
#include <hip/hip_cooperative_groups.h>
#include <cstdio>
#include <cstring>
namespace cg = cooperative_groups;

#ifndef COOP
#define COOP 1
#endif
#define STEPS 0x876543210ull
#define NSTEPS 9

typedef unsigned short u16;
using bf16x8 = __attribute__((ext_vector_type(8))) short;
using s16x4  = __attribute__((ext_vector_type(4))) short;
using f32x4  = __attribute__((ext_vector_type(4))) float;
using f32x16 = __attribute__((ext_vector_type(16))) float;
using u32x4  = __attribute__((ext_vector_type(4))) unsigned;
typedef __attribute__((ext_vector_type(2))) __bf16 bf2_t;
#define DI __device__ __forceinline__
#define MFMA16(a, b, c) __builtin_amdgcn_mfma_f32_16x16x32_bf16((a), (b), (c), 0, 0, 0)
#define MFMA32(a, b, c) __builtin_amdgcn_mfma_f32_32x32x16_bf16((a), (b), (c), 0, 0, 0)
#define EXP2(x) __builtin_amdgcn_exp2f(x)

constexpr int ZW = 4736;
constexpr int FH = 5632;
constexpr int LD2K = 2048 + 64;
constexpr int LDH = 5632 + 64;
constexpr int LDO = 512 + 64;
constexpr int LDS_BYTES = 73728;
constexpr int NPHASE = 9;

struct Params {
  const float *x, *mem, *norm_mix, *w_in, *gate_b, *q_norm, *k_norm_cmp, *k_norm_slc, *k_norm_win,
      *cmp_pos_k, *cmp_pos_v, *cmp_k_w1, *cmp_k_w2, *cmp_v_w1, *cmp_v_w2, *conv_w, *conv_b, *conv_ln_g, *conv_ln_b,
      *w_out, *norm_mem_q, *norm_mem_kv, *w_mq, *w_mk, *w_mv, *mq_norm, *mk_norm, *w_mo, *norm_ffn, *w_gate, *w_up, *w_down;
  float* out;
  u16 *Wt_in, *Wt_mkv, *Wt_out, *Wt_mq, *Wt_mo, *Wt_gu, *Wt_down, *Wt_ck1, *Wt_cv1, *Wt_ck2, *Wt_cv2;
  u16 *actb, *hm, *z, *cat, *hidden, *memK, *memVT, *kcmp, *vcmpT, *vslT, *vwT, *omem;
  float *ybuf, *rowss1, *rowss2, *cstats, *cbias;
  unsigned* bar;
  unsigned long long steps;
  int nsteps, use_cg;
};

typedef const __attribute__((address_space(4))) Params* KP;
DI KP getp() { KP q = (KP)__builtin_amdgcn_kernarg_segment_ptr(); asm volatile("" : "+s"(q)); return q; }

DI int otid() { int t = threadIdx.x; asm volatile("" : "+v"(t)); return t; }
DI float bf2f(u16 v) { return __uint_as_float(((unsigned)v) << 16); }
DI unsigned pack2(float a, float b) { bf2_t v; v[0] = (__bf16)a; v[1] = (__bf16)b; return __builtin_bit_cast(unsigned, v); }
DI u16 f2bf(float a) { return (u16)(pack2(a, 0.f) & 0xffffu); }
DI float rcpf_(float x) { return __builtin_amdgcn_rcpf(x); }
DI float sigm(float x) { return rcpf_(1.f + __expf(-x)); }
DI void lds_barrier() { asm volatile("s_waitcnt lgkmcnt(0)\n\ts_barrier" ::: "memory"); }
DI bf16x8 lds128(const u16* p) { return *reinterpret_cast<const bf16x8*>(p); }

template <int NT>
DI void transpose_tile(const float* __restrict__ src, u16* __restrict__ dst, const float* __restrict__ ks, int K, int N,
                       int mode, int tile, char* smem, int ldd) {
  const int tid = otid();
  const int KT = (K >> 6) / NT;
  const int k0 = (tile % KT) * 64 * NT, n0 = (tile / KT) * 64;
  u16* t = (u16*)smem;
  const int kq = tid >> 4, nq = tid & 15;
  float4 v[NT][4];
#pragma unroll
  for (int q = 0; q < NT; ++q)
#pragma unroll
    for (int r = 0; r < 4; ++r) {
      v[q][r] = make_float4(0.f, 0.f, 0.f, 0.f);
      if (n0 + nq * 4 < N) v[q][r] = *(const float4*)(src + (size_t)(k0 + q * 64 + kq * 4 + r) * N + n0 + nq * 4);
    }
#pragma unroll
  for (int q = 0; q < NT; ++q) {
    if (ks) {
      float4 s = *(const float4*)(ks + k0 + q * 64 + kq * 4);
      v[q][0].x *= s.x; v[q][0].y *= s.x; v[q][0].z *= s.x; v[q][0].w *= s.x;
      v[q][1].x *= s.y; v[q][1].y *= s.y; v[q][1].z *= s.y; v[q][1].w *= s.y;
      v[q][2].x *= s.z; v[q][2].y *= s.z; v[q][2].z *= s.z; v[q][2].w *= s.z;
      v[q][3].x *= s.w; v[q][3].y *= s.w; v[q][3].z *= s.w; v[q][3].w *= s.w;
    }
    __syncthreads();
    {
      uint2 w0, w1, w2, w3;
      w0.x = pack2(v[q][0].x, v[q][1].x); w0.y = pack2(v[q][2].x, v[q][3].x);
      w1.x = pack2(v[q][0].y, v[q][1].y); w1.y = pack2(v[q][2].y, v[q][3].y);
      w2.x = pack2(v[q][0].z, v[q][1].z); w2.y = pack2(v[q][2].z, v[q][3].z);
      w3.x = pack2(v[q][0].w, v[q][1].w); w3.y = pack2(v[q][2].w, v[q][3].w);
      *(uint2*)(t + (nq * 4 + 0) * 72 + kq * 4) = w0;
      *(uint2*)(t + (nq * 4 + 1) * 72 + kq * 4) = w1;
      *(uint2*)(t + (nq * 4 + 2) * 72 + kq * 4) = w2;
      *(uint2*)(t + (nq * 4 + 3) * 72 + kq * 4) = w3;
    }
    __syncthreads();
#pragma unroll
    for (int pass = 0; pass < 2; ++pass) {
      int nn = pass * 32 + (tid >> 3), kc = (tid & 7) * 8;
      uint4 o = *(const uint4*)(t + nn * 72 + kc);
      int n = n0 + nn;
      int drow = n;
      if (mode == 1) drow = (n >> 5) * 64 + (n & 31);
      if (mode == 2) drow = (n >> 5) * 64 + 32 + (n & 31);
      *(uint4*)(dst + (size_t)drow * ldd + k0 + q * 64 + kc) = o;
    }
  }
}

DI void norm_rows_item(KP p, int item) {
  const int lane = otid() & 63, w = otid() >> 6;
  const int row0 = item * 8 + w * 2;
  const float* src; const float* gain; u16* dst;
  if (row0 < 8192) { src = p->x + (size_t)row0 * 2048; gain = p->norm_mix; dst = p->actb + (size_t)row0 * LD2K; }
  else { src = p->mem + (size_t)(row0 - 8192) * 2048; gain = p->norm_mem_kv; dst = p->hm + (size_t)(row0 - 8192) * LD2K; }
  float4 v0[8], v1[8], g[8];
#pragma unroll
  for (int i = 0; i < 8; ++i) { v0[i] = *(const float4*)(src + (i * 64 + lane) * 4); v1[i] = *(const float4*)(src + 2048 + (i * 64 + lane) * 4); }
#pragma unroll
  for (int i = 0; i < 8; ++i) g[i] = *(const float4*)(gain + (i * 64 + lane) * 4);
  float s0 = 0.f, s1 = 0.f;
#pragma unroll
  for (int i = 0; i < 8; ++i) {
    s0 += v0[i].x * v0[i].x + v0[i].y * v0[i].y + v0[i].z * v0[i].z + v0[i].w * v0[i].w;
    s1 += v1[i].x * v1[i].x + v1[i].y * v1[i].y + v1[i].z * v1[i].z + v1[i].w * v1[i].w;
  }
#pragma unroll
  for (int o = 32; o >= 1; o >>= 1) { s0 += __shfl_xor(s0, o); s1 += __shfl_xor(s1, o); }
  const float r0 = rsqrtf(s0 * (1.f / 2048.f) + 1e-6f), r1 = rsqrtf(s1 * (1.f / 2048.f) + 1e-6f);
#pragma unroll
  for (int i = 0; i < 8; ++i) {
    uint2 o0, o1;
    o0.x = pack2(v0[i].x * r0 * g[i].x, v0[i].y * r0 * g[i].y); o0.y = pack2(v0[i].z * r0 * g[i].z, v0[i].w * r0 * g[i].w);
    o1.x = pack2(v1[i].x * r1 * g[i].x, v1[i].y * r1 * g[i].y); o1.y = pack2(v1[i].z * r1 * g[i].z, v1[i].w * r1 * g[i].w);
    *(uint2*)(dst + (i * 64 + lane) * 4) = o0;
    *(uint2*)(dst + LD2K + (i * 64 + lane) * 4) = o1;
  }
}

DI void phase0(KP p, char* smem) {
  const int G = gridDim.x, bid = blockIdx.x;
  constexpr int C0 = 296, C1 = C0 + 32, C2 = C1 + 32, C3 = C2 + 128, C4 = C3 + 32, C5 = C4 + 32, C6 = C5 + 352,
                C7 = C6 + 352, C8 = C7 + 352, C9 = C8 + 16, C10 = C9 + 16, C11 = C10 + 4, C12 = C11 + 4;
  constexpr int NNORM = 1152, NZ = 1;
  const int total = C12 + NNORM + NZ;
  for (int it = bid; it < total; it += G) {
    if (it < C12) {
      if (it < C0) transpose_tile<8>(p->w_in, p->Wt_in, nullptr, 2048, 4632, 0, it, smem, LD2K);
      else if (it < C1) transpose_tile<8>(p->w_mk, p->Wt_mkv, nullptr, 2048, 512, 0, it - C0, smem, LD2K);
      else if (it < C2) transpose_tile<8>(p->w_mv, p->Wt_mkv + (size_t)512 * LD2K, nullptr, 2048, 512, 0, it - C1, smem, LD2K);
      else if (it < C3) transpose_tile<8>(p->w_out, p->Wt_out, nullptr, 2048, 2048, 0, it - C2, smem, LD2K);
      else if (it < C4) transpose_tile<8>(p->w_mq, p->Wt_mq, p->norm_mem_q, 2048, 512, 0, it - C3, smem, LD2K);
      else if (it < C5) transpose_tile<8>(p->w_mo, p->Wt_mo, nullptr, 512, 2048, 0, it - C4, smem, LDO);
      else if (it < C6) transpose_tile<8>(p->w_gate, p->Wt_gu, p->norm_ffn, 2048, 5632, 1, it - C5, smem, LD2K);
      else if (it < C7) transpose_tile<8>(p->w_up, p->Wt_gu, p->norm_ffn, 2048, 5632, 2, it - C6, smem, LD2K);
      else if (it < C8) transpose_tile<8>(p->w_down, p->Wt_down, nullptr, 5632, 2048, 0, it - C7, smem, LDH);
      else if (it < C9) transpose_tile<8>(p->cmp_k_w1, p->Wt_ck1, nullptr, 4096, 128, 0, it - C8, smem, 4096);
      else if (it < C10) transpose_tile<8>(p->cmp_v_w1, p->Wt_cv1, nullptr, 4096, 128, 0, it - C9, smem, 4096);
      else if (it < C11) transpose_tile<1>(p->cmp_k_w2, p->Wt_ck2, nullptr, 128, 128, 0, it - C10, smem, 128);
      else transpose_tile<1>(p->cmp_v_w2, p->Wt_cv2, nullptr, 128, 128, 0, it - C11, smem, 128);
    } else if (it < C12 + NNORM) {
      norm_rows_item(p, it - C12);
    } else {
      for (int i = otid(); i < 8192; i += 256) { p->rowss1[i] = 0.f; p->rowss2[i] = 0.f; p->cstats[2 * i] = 0.f; p->cstats[2 * i + 1] = 0.f; }
    }
  }
}

DI bf16x8 pack8(const f32x16& s, int s2) {
  unsigned a = pack2(s[8 * s2 + 0], s[8 * s2 + 1]);
  unsigned b = pack2(s[8 * s2 + 2], s[8 * s2 + 3]);
  unsigned c = pack2(s[8 * s2 + 4], s[8 * s2 + 5]);
  unsigned d = pack2(s[8 * s2 + 6], s[8 * s2 + 7]);
  uint4 u = make_uint4(a, b, c, d);
  return __builtin_bit_cast(bf16x8, u);
}
DI bf16x8 ldvt(const u16* base) {
  s16x4 lo = *(const s16x4*)(base);
  s16x4 hi = *(const s16x4*)(base + 8);
  return __builtin_shufflevector(lo, hi, 0, 1, 2, 3, 4, 5, 6, 7);
}

template <int MODE, bool QLDS, bool SWZ = false>
DI void flash_tile64(f32x16 (&o)[4], float& m, float& l, const bf16x8 (&qf)[8], const u16* qs, const u16* Ks, const u16* VTs,
                     int key0, int t, float slope, float sc, bool sel, int r, int h, unsigned wlim = 0x80000000u) {
#pragma unroll 1
  for (int sub = 0; sub < 2; ++sub) {
    f32x16 s;
#pragma unroll
    for (int i = 0; i < 16; ++i) s[i] = 0.f;
    if (QLDS) {
#pragma unroll 2
      for (int ks = 0; ks < 8; ++ks) {
        bf16x8 a = lds128(Ks + (sub * 32 + r) * 136 + ks * 16 + h * 8);
        bf16x8 q = lds128(qs + ks * 16);
        s = MFMA32(a, q, s);
      }
    } else {
#pragma unroll
      for (int ks = 0; ks < 8; ++ks) {
        bf16x8 a = SWZ ? lds128(Ks + (sub * 32 + r) * 128 + (((ks * 2 + h) ^ (r & 15)) * 8))
                       : lds128(Ks + (sub * 32 + r) * 136 + ks * 16 + h * 8);
        s = MFMA32(a, qf[ks], s);
      }
    }
    float mx = -1e30f;
    const int rel = t - key0 - sub * 32 - 4 * h;
    const float nbase = -slope * (float)rel;
#pragma unroll
    for (int i = 0; i < 16; ++i) {
      const int ci = (i & 3) + 8 * (i >> 2);
      float v = s[i] * sc;
      if (MODE != 2) v = fmaf(slope, (float)ci, v + nbase);
      if (MODE == 0) { bool ok = sel && ((unsigned)(rel - ci) < wlim); v = ok ? v : -1e30f; }
      s[i] = v;
      mx = fmaxf(mx, v);
      if ((i & 3) == 3) __builtin_amdgcn_sched_barrier(0);
    }
    mx = fmaxf(mx, __shfl_xor(mx, 32));
    float mn = fmaxf(m, mx);
    float alpha = EXP2(m - mn);
    float ps = 0.f;
#pragma unroll
    for (int i = 0; i < 16; ++i) {
      float pv = EXP2(s[i] - mn);
      if (MODE != 2) pv = (s[i] > -1e29f) ? pv : 0.f;
      s[i] = pv;
      ps += pv;
      if ((i & 3) == 3) __builtin_amdgcn_sched_barrier(0);
    }
    l = l * alpha + ps;
    m = mn;
#pragma unroll
    for (int db = 0; db < 4; ++db)
#pragma unroll
      for (int i = 0; i < 16; ++i) o[db][i] *= alpha;
#pragma unroll
    for (int s2 = 0; s2 < 2; ++s2) {
      bf16x8 P = pack8(s, s2);
#pragma unroll
      for (int db = 0; db < 4; ++db) {
        bf16x8 a;
        if (SWZ) {
          const int d = 32 * db + r, sw = (d & 7) ^ ((d >> 3) & 7), ch = sub * 4 + s2 * 2;
          s16x4 lo = *(const s16x4*)(VTs + d * 64 + ((ch ^ sw) * 8) + h * 4);
          s16x4 hi = *(const s16x4*)(VTs + d * 64 + (((ch + 1) ^ sw) * 8) + h * 4);
          a = __builtin_shufflevector(lo, hi, 0, 1, 2, 3, 4, 5, 6, 7);
        } else {
          a = ldvt(VTs + (32 * db + r) * 72 + sub * 32 + 16 * s2 + 4 * h);
        }
        o[db] = MFMA32(a, P, o[db]);
      }
    }
  }
}

DI void stage_tile64(u16* Ks, u16* VTs, const u16* __restrict__ kg, int ldk, const u16* __restrict__ vg, int ldv) {
  const int tid = otid();
  uint4 a[4], b[4];
#pragma unroll
  for (int i = 0; i < 4; ++i) { int c = tid + 256 * i; int key = c >> 4, dc = c & 15; a[i] = *(const uint4*)(kg + (size_t)key * ldk + dc * 8); }
#pragma unroll
  for (int i = 0; i < 4; ++i) { int c = tid + 256 * i; int d = c >> 3, kc = c & 7; b[i] = *(const uint4*)(vg + (size_t)d * ldv + kc * 8); }
#pragma unroll
  for (int i = 0; i < 4; ++i) { int c = tid + 256 * i; int key = c >> 4, dc = c & 15; *(uint4*)(Ks + key * 136 + dc * 8) = a[i]; }
#pragma unroll
  for (int i = 0; i < 4; ++i) { int c = tid + 256 * i; int d = c >> 3, kc = c & 7; *(uint4*)(VTs + d * 72 + kc * 8) = b[i]; }
}

DI void tile_gload(u32x4 (&a)[4], u32x4 (&b)[4], const u16* __restrict__ kg, int ldk, const u16* __restrict__ vg, int ldv, int tid) {
  const unsigned koff = (unsigned)(((tid >> 4) * ldk + (tid & 15) * 8) * 2);
  const unsigned voff = (unsigned)(((tid >> 3) * ldv + (tid & 7) * 8) * 2);
#pragma unroll
  for (int i = 0; i < 4; ++i) a[i] = *(const u32x4*)((const char*)(kg + (size_t)(16 * i) * ldk) + koff);
#pragma unroll
  for (int i = 0; i < 4; ++i) b[i] = *(const u32x4*)((const char*)(vg + (size_t)(32 * i) * ldv) + voff);
}
DI void nsa_dma(const u16* __restrict__ kg, const u16* __restrict__ vg, u16* Kd, u16* Vd, int tid) {
  const int kr = tid >> 4, ksrc = ((tid & 15) ^ (kr & 15)) * 8;
#pragma unroll
  for (int i = 0; i < 4; ++i)
    __builtin_amdgcn_global_load_lds((const unsigned*)(kg + (size_t)(kr + 16 * i) * ZW + ksrc), (unsigned*)(Kd + tid * 8 + i * 2048), 16, 0, 0);
  const int vr = tid >> 3, vp = tid & 7;
#pragma unroll
  for (int i = 0; i < 4; ++i) {
    const int d = vr + 32 * i, sw = (d & 7) ^ ((d >> 3) & 7);
    __builtin_amdgcn_global_load_lds((const unsigned*)(vg + (size_t)d * 2048 + ((vp ^ sw) * 8)), (unsigned*)(Vd + tid * 8 + i * 2048), 16, 0, 0);
  }
}
DI void tile_lstore(u16* Ks, u16* VTs, const u32x4 (&a)[4], const u32x4 (&b)[4], int tid) {
#pragma unroll
  for (int i = 0; i < 4; ++i) { int c = tid + 256 * i; int key = c >> 4, dc = c & 15; *(u32x4*)(Ks + key * 136 + dc * 8) = a[i]; }
#pragma unroll
  for (int i = 0; i < 4; ++i) { int c = tid + 256 * i; int d = c >> 3, kc = c & 7; *(u32x4*)(VTs + d * 72 + kc * 8) = b[i]; }
}

DI void nsa_item(KP p, int item, char* smem) {
  const int tid = otid(), lane = tid & 63, w = tid >> 6, r = lane & 31, h = lane >> 5;
  const int tq = 63 - (item >> 3), g = item & 1, b = (item >> 1) & 3;
  const int t0 = tq * 32, qi = r >> 2, hg = r & 3, t = t0 + w * 8 + qi, head = g * 4 + hg;
  const size_t zrow = (size_t)(b * 2048 + t) * ZW;
  bf16x8 qf[8];
#pragma unroll
  for (int ks = 0; ks < 8; ++ks) qf[ks] = *(const bf16x8*)(p->z + zrow + head * 128 + ks * 16 + h * 8);
  const float L2E = 1.44269504089f;
  const float sc = 0.08838834764831845f * L2E;
  const float slope = EXP2(-(float)(head + 1)) * L2E;
#define NSA_GATE(br) sigm(bf2f(p->z[(size_t)(b * 2048 + t) * ZW + 2560 + head * 3 + (br)]) + p->gate_b[head * 3 + (br)])

  u16* Kc = (u16*)smem;
  u16* VTc = Kc + 128 * 136;
  unsigned* maskS = (unsigned*)(smem + 73600);
  u16* Qs = (u16*)(smem + 35840);
  float* impS = (float*)smem;
  u16* Ks = (u16*)smem;
  u16* VTs = Ks + 64 * 136;

  {
    const u16* kcg = p->kcmp + (size_t)(b * 2 + g) * 128 * 128;
    const u16* vcg = p->vcmpT + (size_t)(b * 2 + g) * 128 * 128;
    __syncthreads();
#pragma unroll 8
    for (int i = 0; i < 8; ++i) {
      int c = tid + 256 * i; int row = c >> 4, c16 = c & 15;
      *(uint4*)(Kc + row * 136 + c16 * 8) = *(const uint4*)(kcg + row * 128 + c16 * 8);
      *(uint4*)(VTc + row * 136 + c16 * 8) = *(const uint4*)(vcg + row * 128 + c16 * 8);
    }
    if (tid < 32) maskS[tid] = 0u;
    __syncthreads();
  }
#define NSA_OB (p->out + (size_t)(b * 2048 + t) * 2048 + head * 128 + 4 * h)
  {
    float mx = -1e30f, lsum = 0.f;
#pragma unroll 1
    for (int kt = 0; kt < 4; ++kt) {
      f32x16 s;
#pragma unroll
      for (int i = 0; i < 16; ++i) s[i] = 0.f;
#pragma unroll
      for (int ks = 0; ks < 8; ++ks) {
        bf16x8 a = lds128(Kc + (kt * 32 + r) * 136 + ks * 16 + h * 8);
        s = MFMA32(a, qf[ks], s);
      }
      float tmx = -1e30f;
      const int relc = t - 64 * h - 512 * kt;
      const float nb = -slope * ((float)relc - 15.5f);
#pragma unroll
      for (int i = 0; i < 16; ++i) {
        const int ci = (i & 3) + 8 * (i >> 2);
        bool ok = (relc >= 16 * ci + 31);
        float v = fmaf(slope, (float)(16 * ci), fmaf(s[i], sc, nb));
        v = ok ? v : -1e30f;
        s[i] = v;
        tmx = fmaxf(tmx, v);
      }
      tmx = fmaxf(tmx, __shfl_xor(tmx, 32));
      float mn = fmaxf(mx, tmx);
      float ps = 0.f;
#pragma unroll
      for (int i = 0; i < 16; ++i) ps += (s[i] > -1e29f) ? EXP2(s[i] - mn) : 0.f;
      lsum = lsum * EXP2(mx - mn) + ps;
      mx = mn;
    }
    lsum += __shfl_xor(lsum, 32);
    const float inv = lsum > 0.f ? rcpf_(lsum) : 0.f;
    float imp[16];
    float carry_in = 0.f;
    f32x16 o[4];
#pragma unroll
    for (int db = 0; db < 4; ++db)
#pragma unroll
      for (int i = 0; i < 16; ++i) o[db][i] = 0.f;
#pragma unroll
    for (int kt = 0; kt < 4; ++kt) {
      f32x16 s;
#pragma unroll
      for (int i = 0; i < 16; ++i) s[i] = 0.f;
#pragma unroll
      for (int ks = 0; ks < 8; ++ks) {
        bf16x8 a = lds128(Kc + (kt * 32 + r) * 136 + ks * 16 + h * 8);
        s = MFMA32(a, qf[ks], s);
      }
      const int relc = t - 64 * h - 512 * kt;
      const float nb = -slope * ((float)relc - 15.5f) - mx;
#pragma unroll
      for (int i = 0; i < 16; ++i) {
        const int ci = (i & 3) + 8 * (i >> 2);
        bool ok = (relc >= 16 * ci + 31);
        float v = fmaf(slope, (float)(16 * ci), fmaf(s[i], sc, nb));
        s[i] = ok ? EXP2(v) * inv : 0.f;
      }
#pragma unroll
      for (int b4 = 0; b4 < 4; ++b4) {
        float p0 = s[4 * b4], p1 = s[4 * b4 + 1], p2 = s[4 * b4 + 2], p3 = s[4 * b4 + 3];
        float rc = __shfl_xor(0.5f * p3, 32);
        imp[kt * 4 + b4] = p0 + p1 + p2 + 0.5f * p3 + (h ? rc : carry_in);
        carry_in = rc;
      }
      __builtin_amdgcn_sched_barrier(0);
#pragma unroll
      for (int s2 = 0; s2 < 2; ++s2) {
        bf16x8 P = pack8(s, s2);
#pragma unroll
        for (int db = 0; db < 4; ++db) {
          bf16x8 a = ldvt(VTc + (32 * db + r) * 136 + kt * 32 + 16 * s2 + 4 * h);
          o[db] = MFMA32(a, P, o[db]);
        }
        __builtin_amdgcn_sched_barrier(0);
      }
    }
    const float g0 = NSA_GATE(0);
#pragma unroll
    for (int db = 0; db < 4; ++db)
#pragma unroll
      for (int i4 = 0; i4 < 4; ++i4)
        *(float4*)(NSA_OB + 32 * db + 8 * i4) = make_float4(g0 * o[db][4 * i4], g0 * o[db][4 * i4 + 1], g0 * o[db][4 * i4 + 2], g0 * o[db][4 * i4 + 3]);
#pragma unroll
    for (int i = 0; i < 16; ++i) { imp[i] += __shfl_xor(imp[i], 1); imp[i] += __shfl_xor(imp[i], 2); }
    __syncthreads();
    if (hg == 0) {
#pragma unroll
      for (int i = 0; i < 16; ++i) impS[(w * 8 + qi) * 32 + 2 * i + h] = imp[i];
    }
    __syncthreads();
    {
      const int ql = tid >> 3, part = tid & 7;
      const int tqq = t0 + ql, cur = tqq >> 6;
      float scs[32];
#pragma unroll
      for (int j = 0; j < 32; ++j) {
        float v = impS[ql * 32 + j];
        bool valid = (j * 64 <= tqq);
        bool forced = (j == 0) || (j == cur) || (j == cur - 1);
        scs[j] = valid ? v + (forced ? 1000.f : 0.f) : -1e30f;
      }
      unsigned mb = 0u;
#pragma unroll
      for (int ii = 0; ii < 4; ++ii) {
        const int ci = part * 4 + ii;
        float v = impS[ql * 32 + ci];
        bool valid = (ci * 64 <= tqq);
        bool forced = (ci == 0) || (ci == cur) || (ci == cur - 1);
        float si = valid ? v + (forced ? 1000.f : 0.f) : -1e30f;
        int rank = 0;
#pragma unroll
        for (int j = 0; j < 32; ++j) rank += ((scs[j] > si) || (scs[j] == si && j < ci)) ? 1 : 0;
        if (rank < 16) mb |= (1u << ci);
      }
      atomicOr(&maskS[ql], mb);
    }
    __syncthreads();
  }
  unsigned mymask = maskS[w * 8 + qi];
  unsigned uni = 0u;
#pragma unroll
  for (int j = 0; j < 32; ++j) uni |= maskS[j];
  uni = __builtin_amdgcn_readfirstlane(uni);

  {
    f32x16 o[4];
#pragma unroll
    for (int db = 0; db < 4; ++db)
#pragma unroll
      for (int i = 0; i < 16; ++i) o[db][i] = 0.f;
    float m = -1e30f, l = 0.f;
    const int cmax = (t0 + 31) >> 6;
    const unsigned uni_c = uni & (cmax >= 31 ? 0xffffffffu : ((2u << cmax) - 1u));
    const int n_slc = __popc(uni_c);
    int lo = t0 - 511; lo = lo < 0 ? 0 : lo; lo >>= 6;
    const int total = n_slc + (cmax - lo + 1);
    const u16* kb_s = p->z + (size_t)(b * 2048) * ZW + 1536 + g * 128;
    const u16* vb_s = p->vslT + (size_t)(b * 2 + g) * 128 * 2048;
    const u16* kb_w = p->z + (size_t)(b * 2048) * ZW + 2048 + g * 128;
    const u16* vb_w = p->vwT + (size_t)(b * 2 + g) * 128 * 2048;
    unsigned rem = uni_c;
    u16* Kb0 = (u16*)smem;            u16* Vb0 = Kb0 + 8192;
    u16* Kb1 = Kb0 + 16384;           u16* Vb1 = Kb1 + 8192;
    int blk_nxt = __ffs(rem) - 1; rem &= rem - 1u;
    nsa_dma(kb_s + (size_t)(blk_nxt * 64) * ZW, vb_s + blk_nxt * 64, Kb0, Vb0, tid);
    for (int i = 0; i < total; ++i) {
      const int blk = blk_nxt;
      asm volatile("s_waitcnt vmcnt(0)" ::: "memory");
      __syncthreads();
      const u16* Ks = (i & 1) ? Kb1 : Kb0;
      const u16* VTs = (i & 1) ? Vb1 : Vb0;
      if (i + 1 < total) {
        u16* Kn = (i & 1) ? Kb0 : Kb1;
        u16* Vn = (i & 1) ? Vb0 : Vb1;
        if (i + 1 < n_slc) {
          blk_nxt = __builtin_amdgcn_readfirstlane(__ffs(rem) - 1); rem &= rem - 1u;
          nsa_dma(kb_s + (size_t)(blk_nxt * 64) * ZW, vb_s + blk_nxt * 64, Kn, Vn, tid);
        } else {
          blk_nxt = lo + (i + 1 - n_slc);
          nsa_dma(kb_w + (size_t)(blk_nxt * 64) * ZW, vb_w + blk_nxt * 64, Kn, Vn, tid);
        }
      }
      {
        const bool is_slc = i < n_slc;
        const bool sel = is_slc ? ((((mymask >> blk) & 1u) != 0u) && (blk * 64 <= t)) : true;
        if (__ballot(sel) != 0ull) flash_tile64<0, false, true>(o, m, l, qf, nullptr, Ks, VTs, blk * 64, t, slope, sc, sel, r, h, is_slc ? 0x80000000u : 512u);
        if (i == n_slc - 1) {
          float lt = l + __shfl_xor(l, 32);
          float f = NSA_GATE(1) * (lt > 0.f ? rcpf_(lt) : 0.f);
#pragma unroll
          for (int db = 0; db < 4; ++db)
#pragma unroll
            for (int i4 = 0; i4 < 4; ++i4) {
              float4 pv = *(const float4*)(NSA_OB + 32 * db + 8 * i4);
              pv.x += f * o[db][4 * i4]; pv.y += f * o[db][4 * i4 + 1]; pv.z += f * o[db][4 * i4 + 2]; pv.w += f * o[db][4 * i4 + 3];
              *(float4*)(NSA_OB + 32 * db + 8 * i4) = pv;
              if (i4 == 3) __builtin_amdgcn_sched_barrier(0);
            }
#pragma unroll
          for (int db = 0; db < 4; ++db)
#pragma unroll
            for (int q = 0; q < 16; ++q) o[db][q] = 0.f;
          m = -1e30f; l = 0.f;
        }
      }
    }
    float lt = l + __shfl_xor(l, 32);
    float f = NSA_GATE(2) * (lt > 0.f ? rcpf_(lt) : 0.f);
    u16* dst = p->cat + (size_t)(b * 2048 + t) * LD2K + head * 128;
#pragma unroll
    for (int db = 0; db < 4; ++db)
#pragma unroll
      for (int i4 = 0; i4 < 4; ++i4) {
        float4 pv = *(const float4*)(NSA_OB + 32 * db + 8 * i4);
        pv.x += f * o[db][4 * i4]; pv.y += f * o[db][4 * i4 + 1]; pv.z += f * o[db][4 * i4 + 2]; pv.w += f * o[db][4 * i4 + 3];
        uint2 v; v.x = pack2(pv.x, pv.y); v.y = pack2(pv.z, pv.w);
        *(uint2*)(dst + 32 * db + 8 * i4 + 4 * h) = v;
        if (i4 == 3) __builtin_amdgcn_sched_barrier(0);
      }
  }
}

DI void compress_item(KP p, int item, char* smem) {
  const int tid = otid(), lane = tid & 63, w = tid >> 6, fr = lane & 15, fq = lane >> 4;
  const int ct = item & 7, g = (item >> 3) & 1, b = (item >> 4) & 3, kv = item >> 6;
  const u16* W1 = kv ? p->Wt_cv1 : p->Wt_ck1;
  const u16* W2 = kv ? p->Wt_cv2 : p->Wt_ck2;
  const int zc = (kv ? 1280 : 1024) + g * 128;
  const int c = ct * 16 + fr;
  const bool cval = c < 127;
  float* part = (float*)smem;
  u16* h1s = (u16*)(smem + 32768);
  float* red = (float*)(smem + 32768 + 4352);
  f32x4 acc[8];
#pragma unroll
  for (int n = 0; n < 8; ++n) acc[n] = (f32x4){0.f, 0.f, 0.f, 0.f};
  const u16* zb = p->z + (size_t)(b * 2048 + 16 * (cval ? c : 0)) * ZW + zc;
  const u16* w1b = W1 + (size_t)fr * 4096 + w * 1024 + fq * 8;
#pragma unroll 4
  for (int ks = 0; ks < 32; ++ks) {
    const int k = w * 1024 + ks * 32 + fq * 8;
    const int l = k >> 7, d = k & 127;
    u32x4 raw = *(const u32x4*)(zb + (size_t)l * ZW + d);
    if (!cval) raw = (u32x4){0u, 0u, 0u, 0u};
    const bf16x8 a = __builtin_bit_cast(bf16x8, raw);
#pragma unroll
    for (int n = 0; n < 8; ++n) {
      bf16x8 bfr = *(const bf16x8*)(w1b + (size_t)(n * 16) * 4096 + ks * 32);
      acc[n] = MFMA16(a, bfr, acc[n]);
    }
  }
  __syncthreads();
#pragma unroll
  for (int n = 0; n < 8; ++n)
#pragma unroll
    for (int j = 0; j < 4; ++j) part[(w * 16 + fq * 4 + j) * 128 + n * 16 + fr] = acc[n][j];
  __syncthreads();
  {
    const int row = tid >> 4, c0 = (tid & 15) * 8;
#pragma unroll
    for (int e = 0; e < 8; ++e) {
      float v = part[(0 * 16 + row) * 128 + c0 + e] + part[(1 * 16 + row) * 128 + c0 + e] + part[(2 * 16 + row) * 128 + c0 + e] +
                part[(3 * 16 + row) * 128 + c0 + e] + p->cbias[kv * 128 + c0 + e];
      h1s[row * 136 + c0 + e] = (ct * 16 + row < 127) ? f2bf(v * sigm(v)) : (u16)0;
    }
  }
  __syncthreads();
  f32x4 acc2[2];
  acc2[0] = (f32x4){0.f, 0.f, 0.f, 0.f};
  acc2[1] = (f32x4){0.f, 0.f, 0.f, 0.f};
#pragma unroll
  for (int ks = 0; ks < 4; ++ks) {
    bf16x8 a = lds128(h1s + fr * 136 + ks * 32 + fq * 8);
#pragma unroll
    for (int nn = 0; nn < 2; ++nn) {
      bf16x8 bfr = *(const bf16x8*)(W2 + (size_t)((2 * w + nn) * 16 + fr) * 128 + ks * 32 + fq * 8);
      acc2[nn] = MFMA16(a, bfr, acc2[nn]);
    }
  }
  if (kv == 0) {
    float ss[4];
#pragma unroll
    for (int j = 0; j < 4; ++j) {
      ss[j] = acc2[0][j] * acc2[0][j] + acc2[1][j] * acc2[1][j];
      ss[j] += __shfl_xor(ss[j], 1); ss[j] += __shfl_xor(ss[j], 2); ss[j] += __shfl_xor(ss[j], 4); ss[j] += __shfl_xor(ss[j], 8);
    }
    if (fr == 0) {
#pragma unroll
      for (int j = 0; j < 4; ++j) red[w * 16 + fq * 4 + j] = ss[j];
    }
    __syncthreads();
#pragma unroll
    for (int j = 0; j < 4; ++j) {
      const int row = fq * 4 + j;
      float tot = red[row] + red[16 + row] + red[32 + row] + red[48 + row];
      float rs = rsqrtf(tot * (1.f / 128.f) + 1e-6f);
#pragma unroll
      for (int nn = 0; nn < 2; ++nn) {
        const int col = (2 * w + nn) * 16 + fr;
        p->kcmp[((size_t)(b * 2 + g) * 128 + ct * 16 + row) * 128 + col] = f2bf(acc2[nn][j] * rs * p->k_norm_cmp[col]);
      }
    }
  } else {
#pragma unroll
    for (int nn = 0; nn < 2; ++nn) {
      const int col = (2 * w + nn) * 16 + fr;
      uint2 v; v.x = pack2(acc2[nn][0], acc2[nn][1]); v.y = pack2(acc2[nn][2], acc2[nn][3]);
      *(uint2*)(p->vcmpT + ((size_t)(b * 2 + g) * 128 + col) * 128 + ct * 16 + fq * 4) = v;
    }
  }
  __syncthreads();
}

DI void cbias_item(KP p, int item) {
  const int tid = otid(), lane = tid & 63, w = tid >> 6;
  const int o = item * 4 + w;
  const int kv = o >> 7, n = o & 127;
  const u16* W1 = (kv ? p->Wt_cv1 : p->Wt_ck1) + (size_t)n * 4096;
  const float* pos = kv ? p->cmp_pos_v : p->cmp_pos_k;
  float s = 0.f;
#pragma unroll
  for (int i = 0; i < 8; ++i) {
    const int k = (i * 64 + lane) * 8;
    u32x4 wv = *(const u32x4*)(W1 + k);
    float4 p0 = *(const float4*)(pos + k), p1 = *(const float4*)(pos + k + 4);
    s += __uint_as_float(wv[0] << 16) * p0.x + __uint_as_float(wv[0] & 0xffff0000u) * p0.y;
    s += __uint_as_float(wv[1] << 16) * p0.z + __uint_as_float(wv[1] & 0xffff0000u) * p0.w;
    s += __uint_as_float(wv[2] << 16) * p1.x + __uint_as_float(wv[2] & 0xffff0000u) * p1.y;
    s += __uint_as_float(wv[3] << 16) * p1.z + __uint_as_float(wv[3] & 0xffff0000u) * p1.w;
  }
#pragma unroll
  for (int off = 32; off >= 1; off >>= 1) s += __shfl_xor(s, off);
  if (lane == 0) p->cbias[o] = s;
}

DI void conv_item(KP p, int item, char* smem) {
  const int tid = otid();
  const int chunk = item & 7, t0 = ((item >> 3) & 63) * 32, b = item >> 9;
  const int cl = tid & 127, th = tid >> 7;
  const int ch0 = chunk * 128;
  float* hs = (float*)smem;
  __syncthreads();
  {
    const int cq = tid & 31, rg = tid >> 5;
    uint2 ua[8], ub[8];
    const u16* zc = p->z + (size_t)(b * 2048) * ZW + 2584 + ch0 + cq * 4;
#pragma unroll
    for (int i = 0; i < 8; ++i) {
      int tok = t0 - 30 + rg + 8 * i;
      tok = tok < 0 ? 0 : (tok > 2047 ? 2047 : tok);
      ua[i] = *(const uint2*)(zc + (size_t)tok * ZW); ub[i] = *(const uint2*)(zc + (size_t)tok * ZW + 1024);
    }
#pragma unroll
    for (int i = 0; i < 8; ++i) {
      const int row = rg + 8 * i, tok = t0 - 30 + row;
      float4 hv;
      hv.x = __uint_as_float(ua[i].x << 16) * sigm(__uint_as_float(ub[i].x << 16));
      hv.y = __uint_as_float(ua[i].x & 0xffff0000u) * sigm(__uint_as_float(ub[i].x & 0xffff0000u));
      hv.z = __uint_as_float(ua[i].y << 16) * sigm(__uint_as_float(ub[i].y << 16));
      hv.w = __uint_as_float(ua[i].y & 0xffff0000u) * sigm(__uint_as_float(ub[i].y & 0xffff0000u));
      if (tok < 0) hv = make_float4(0.f, 0.f, 0.f, 0.f);
      if (row < 62) *(float4*)(hs + row * 128 + cq * 4) = hv;
    }
  }
  float wv[31];
#pragma unroll
  for (int j = 0; j < 31; ++j) wv[j] = p->conv_w[j * 1024 + ch0 + cl];
  const float bias = p->conv_b[ch0 + cl];
  __syncthreads();
  float y[16];
  {
    float v[46];
#pragma unroll
    for (int i = 0; i < 46; ++i) v[i] = hs[(th * 16 + i) * 128 + cl];
#pragma unroll
    for (int i = 0; i < 16; ++i) y[i] = bias;
#pragma unroll
    for (int j = 0; j < 31; ++j) {
#pragma unroll
      for (int i = 0; i < 16; ++i) y[i] += wv[j] * v[i + j];
    }
  }
  float* yb = p->ybuf + (size_t)(b * 2048 + t0 + th * 16) * 1024 + ch0 + cl;
  __syncthreads();
#pragma unroll
  for (int i = 0; i < 16; ++i) { yb[i * 1024] = y[i]; hs[(th * 16 + i) * 128 + cl] = y[i]; }
  __syncthreads();
  {
    const int tok = tid >> 3, part = tid & 7;
    float a1 = 0.f, a2 = 0.f;
#pragma unroll
    for (int i = 0; i < 16; ++i) { float v = hs[tok * 128 + i * 8 + part]; a1 += v; a2 += v * v; }
    a1 += __shfl_xor(a1, 1); a2 += __shfl_xor(a2, 1);
    a1 += __shfl_xor(a1, 2); a2 += __shfl_xor(a2, 2);
    a1 += __shfl_xor(a1, 4); a2 += __shfl_xor(a2, 4);
    if (part == 0) { atomicAdd(&p->cstats[(size_t)(b * 2048 + t0 + tok) * 2], a1); atomicAdd(&p->cstats[(size_t)(b * 2048 + t0 + tok) * 2 + 1], a2); }
  }
}

DI void conv_fin_item(KP p, int item) {
  const int tid = otid();
  const float4 gg = *(const float4*)(p->conv_ln_g + tid * 4), bt = *(const float4*)(p->conv_ln_b + tid * 4);
#pragma unroll 8
  for (int i = 0; i < 16; ++i) {
    const size_t row = (size_t)item * 16 + i;
    const float mu = p->cstats[row * 2] * (1.f / 1024.f);
    const float var = p->cstats[row * 2 + 1] * (1.f / 1024.f) - mu * mu;
    const float rstd = rsqrtf(fmaxf(var, 0.f) + 1e-5f);
    float4 yv = *(const float4*)(p->ybuf + row * 1024 + tid * 4);
    float a = (yv.x - mu) * rstd * gg.x + bt.x, bq = (yv.y - mu) * rstd * gg.y + bt.y;
    float c = (yv.z - mu) * rstd * gg.z + bt.z, d = (yv.w - mu) * rstd * gg.w + bt.w;
    uint2 o; o.x = pack2(a * sigm(a), bq * sigm(bq)); o.y = pack2(c * sigm(c), d * sigm(d));
    *(uint2*)(p->cat + row * LD2K + 1024 + tid * 4) = o;
  }
}

enum { E_IN = 0, E_MKV = 1, E_RES1 = 2, E_MQ = 3, E_RES2 = 4, E_GU = 5, E_FIN = 6 };

struct GStage { u32x4 a0, a1, a2, a3, b0, b1, b2, b3; };
DI void gemm_gload(GStage& s, const u16* __restrict__ Ag, const u16* __restrict__ Bg, int lda, int ldb, int kt) {
  s.a0 = *(const u32x4*)(Ag + kt * 64);
  s.a1 = *(const u32x4*)(Ag + (size_t)32 * lda + kt * 64);
  s.a2 = *(const u32x4*)(Ag + (size_t)64 * lda + kt * 64);
  s.a3 = *(const u32x4*)(Ag + (size_t)96 * lda + kt * 64);
  s.b0 = *(const u32x4*)(Bg + kt * 64);
  s.b1 = *(const u32x4*)(Bg + (size_t)32 * ldb + kt * 64);
  s.b2 = *(const u32x4*)(Bg + (size_t)64 * ldb + kt * 64);
  s.b3 = *(const u32x4*)(Bg + (size_t)96 * ldb + kt * 64);
}
DI void gemm_lstore(const GStage& s, u16* As, u16* Bs, int lrow, int lsw) {
  u16* a = As + lrow * 64 + lsw;
  u16* b = Bs + lrow * 64 + lsw;
  *(u32x4*)(a) = s.a0; *(u32x4*)(a + 32 * 64) = s.a1; *(u32x4*)(a + 64 * 64) = s.a2; *(u32x4*)(a + 96 * 64) = s.a3;
  *(u32x4*)(b) = s.b0; *(u32x4*)(b + 32 * 64) = s.b1; *(u32x4*)(b + 64 * 64) = s.b2; *(u32x4*)(b + 96 * 64) = s.b3;
}
DI void gemm_rdfrag(bf16x8 (&a)[4], bf16x8 (&bfr)[4], const u16* Ab, const u16* Bb, int rc) {
#pragma unroll
  for (int m = 0; m < 4; ++m) a[m] = lds128(Ab + m * 16 * 64 + rc);
#pragma unroll
  for (int n = 0; n < 4; ++n) bfr[n] = lds128(Bb + n * 16 * 64 + rc);
}
DI void gemm_mma(f32x4 (&acc)[4][4], const bf16x8 (&a)[4], const bf16x8 (&bfr)[4]) {
#pragma unroll
  for (int m = 0; m < 4; ++m)
#pragma unroll
    for (int n = 0; n < 4; ++n) acc[m][n] = MFMA16(a[m], bfr[n], acc[m][n]);
}
#define SB __builtin_amdgcn_sched_barrier(0)

template <int EPI>
DI void gemm_tile(KP p, const u16* __restrict__ A, int lda, const u16* __restrict__ Bt, int ldb, int K, int tm,
                  int tn, char* smem) {
  const int tid = otid(), lane = tid & 63, w = tid >> 6, wr = w >> 1, wc = w & 1, fr = lane & 15, fq = lane >> 4;
  u16* As = (u16*)smem;
  u16* Bs = As + 2 * 128 * 64;
  f32x4 acc[4][4];
#pragma unroll
  for (int m = 0; m < 4; ++m)
#pragma unroll
    for (int n = 0; n < 4; ++n) acc[m][n] = (f32x4){0.f, 0.f, 0.f, 0.f};
  const int lrow = tid >> 3, lkc = (tid & 7) * 8;
  const int lsw = (((tid & 7) ^ ((lrow >> 1) & 7)) * 8);
  const int rc0 = ((fq ^ (fr >> 1)) * 8), rc1 = rc0 ^ 32;
  const u16* Ag = A + (size_t)(tm * 128 + lrow) * lda + lkc;
  const u16* Bg = Bt + (size_t)(tn * 128 + lrow) * ldb + lkc;
  float rsc[4][4];
  if (EPI == E_GU || EPI == E_MQ) {
    const float* rs_src = (EPI == E_GU) ? p->rowss2 : p->rowss1;
#pragma unroll
    for (int m = 0; m < 4; ++m)
#pragma unroll
      for (int j = 0; j < 4; ++j) rsc[m][j] = rs_src[tm * 128 + wr * 64 + m * 16 + fq * 4 + j];
  }
  const int nk = K >> 6;
  const u16* Ab = As + (wr * 64 + fr) * 64;
  const u16* Bb = Bs + (wc * 64 + fr) * 64;
  bf16x8 fa0[4], fb0[4];
  if (false) {
    GStage g0, g1;
    gemm_gload(g0, Ag, Bg, lda, ldb, 0);
    gemm_lstore(g0, As, Bs, lrow, lsw);
    gemm_gload(g0, Ag, Bg, lda, ldb, 1);
    gemm_gload(g1, Ag, Bg, lda, ldb, 2);
    lds_barrier();
    for (int kt = 0; kt < nk; kt += 2) {
      gemm_rdfrag(fa0, fb0, Ab, Bb, rc0);
      SB; gemm_mma(acc, fa0, fb0); SB;
      gemm_rdfrag(fa0, fb0, Ab, Bb, rc1);
      gemm_lstore(g0, As + 128 * 64, Bs + 128 * 64, lrow, lsw);
      if (kt + 3 < nk) gemm_gload(g0, Ag, Bg, lda, ldb, kt + 3);
      SB; gemm_mma(acc, fa0, fb0); SB;
      lds_barrier();
      gemm_rdfrag(fa0, fb0, Ab + 128 * 64, Bb + 128 * 64, rc0);
      SB; gemm_mma(acc, fa0, fb0); SB;
      gemm_rdfrag(fa0, fb0, Ab + 128 * 64, Bb + 128 * 64, rc1);
      if (kt + 2 < nk) gemm_lstore(g1, As, Bs, lrow, lsw);
      if (kt + 4 < nk) gemm_gload(g1, Ag, Bg, lda, ldb, kt + 4);
      SB; gemm_mma(acc, fa0, fb0); SB;
      lds_barrier();
    }
  } else {
    const u16* Agd = A + (size_t)(tm * 128 + lrow) * lda + lsw;
    const u16* Bgd = Bt + (size_t)(tn * 128 + lrow) * ldb + lsw;
#define GDMA(KT, BUF)                                                                                                      \
    _Pragma("unroll") for (int i = 0; i < 4; ++i) {                                                                        \
      __builtin_amdgcn_global_load_lds((const unsigned*)(Agd + (size_t)(32 * i) * lda + (KT) * 64),                        \
                                       (unsigned*)(As + (BUF) * 128 * 64 + tid * 8 + i * 2048), 16, 0, 0);                 \
      __builtin_amdgcn_global_load_lds((const unsigned*)(Bgd + (size_t)(32 * i) * ldb + (KT) * 64),                        \
                                       (unsigned*)(Bs + (BUF) * 128 * 64 + tid * 8 + i * 2048), 16, 0, 0);                 \
    }
    GDMA(0, 0)
    asm volatile("s_waitcnt vmcnt(0)" ::: "memory");
    lds_barrier();
    bf16x8 fa1[4], fb1[4];
#define GHALF(ABUF, BBUF)                                                                         \
      gemm_rdfrag(fa0, fb0, ABUF, BBUF, rc0);                                                     \
      SB;                                                                                         \
      gemm_mma(acc, fa0, fb0); gemm_rdfrag(fa1, fb1, ABUF, BBUF, rc1);                            \
      _Pragma("unroll") for (int q = 0; q < 8; ++q) {                                             \
        __builtin_amdgcn_sched_group_barrier(0x008, 2, 0);                                        \
        __builtin_amdgcn_sched_group_barrier(0x100, 1, 0);                                        \
      }                                                                                           \
      SB;                                                                                         \
      gemm_mma(acc, fa1, fb1);                                                                    \
      SB;
    for (int kt = 0; kt < nk; kt += 2) {
      if (kt + 1 < nk) { GDMA(kt + 1, 1) }
      GHALF(Ab, Bb)
      asm volatile("s_waitcnt vmcnt(0)" ::: "memory");
      lds_barrier();
      if (kt + 2 < nk) { GDMA(kt + 2, 0) }
      GHALF(Ab + 128 * 64, Bb + 128 * 64)
      asm volatile("s_waitcnt vmcnt(0)" ::: "memory");
      lds_barrier();
    }
#undef GHALF
#undef GDMA
  }
  u16* Cs = (u16*)smem;
  float* red = (float*)(smem + 34816);
  if (EPI == E_IN || EPI == E_MKV || EPI == E_MQ) {
    bool donorm = false, transposed = false;
    const float* gain = nullptr;
    u16* dst = nullptr;
    int ldd = 0;
    if (EPI == E_IN) {
      dst = p->z + (size_t)(tm * 128) * ZW + tn * 128; ldd = ZW;
      if (tn < 8) { donorm = true; gain = p->q_norm; }
      else if (tn == 12 || tn == 13) { donorm = true; gain = p->k_norm_slc; }
      else if (tn == 16 || tn == 17) { donorm = true; gain = p->k_norm_win; }
      else if (tn == 14 || tn == 15) { transposed = true; dst = p->vslT + (size_t)(((tm >> 4) * 2 + (tn & 1)) * 128) * 2048 + (tm & 15) * 128; ldd = 2048; }
      else if (tn == 18 || tn == 19) { transposed = true; dst = p->vwT + (size_t)(((tm >> 4) * 2 + (tn & 1)) * 128) * 2048 + (tm & 15) * 128; ldd = 2048; }
    } else if (EPI == E_MKV) {
      if (tn < 4) { donorm = true; gain = p->mk_norm; dst = p->memK + (size_t)(tm * 128) * 512 + tn * 128; ldd = 512; }
      else { transposed = true; dst = p->memVT + (size_t)(((tm >> 1) * 4 + (tn - 4)) * 128) * 256 + (tm & 1) * 128; ldd = 256; }
    } else {
      donorm = true; gain = p->mq_norm;
#pragma unroll
      for (int m = 0; m < 4; ++m)
#pragma unroll
        for (int j = 0; j < 4; ++j) {
          float sr = rsqrtf(rsc[m][j] * (1.f / 2048.f) + 1e-6f);
#pragma unroll
          for (int n = 0; n < 4; ++n) acc[m][n][j] *= sr;
        }
    }
    if (donorm) {
#pragma unroll
      for (int m = 0; m < 4; ++m)
#pragma unroll
        for (int j = 0; j < 4; ++j) {
          float ss = 0.f;
#pragma unroll
          for (int n = 0; n < 4; ++n) ss += acc[m][n][j] * acc[m][n][j];
          ss += __shfl_xor(ss, 1); ss += __shfl_xor(ss, 2); ss += __shfl_xor(ss, 4); ss += __shfl_xor(ss, 8);
          if (fr == 0) red[wc * 128 + wr * 64 + m * 16 + fq * 4 + j] = ss;
        }
      __syncthreads();
#pragma unroll
      for (int m = 0; m < 4; ++m)
#pragma unroll
        for (int j = 0; j < 4; ++j) {
          const int rl = wr * 64 + m * 16 + fq * 4 + j;
          float rs = rsqrtf((red[rl] + red[128 + rl]) * (1.f / 128.f) + 1e-6f);
#pragma unroll
          for (int n = 0; n < 4; ++n) acc[m][n][j] *= rs * gain[wc * 64 + n * 16 + fr];
        }
    }
    if (!transposed) {
#pragma unroll
      for (int m = 0; m < 4; ++m)
#pragma unroll
        for (int n = 0; n < 4; ++n)
#pragma unroll
          for (int j = 0; j < 4; ++j) Cs[(wr * 64 + m * 16 + fq * 4 + j) * 136 + wc * 64 + n * 16 + fr] = f2bf(acc[m][n][j]);
    } else {
#pragma unroll
      for (int m = 0; m < 4; ++m)
#pragma unroll
        for (int n = 0; n < 4; ++n) {
          uint2 v; v.x = pack2(acc[m][n][0], acc[m][n][1]); v.y = pack2(acc[m][n][2], acc[m][n][3]);
          *(uint2*)(Cs + (wc * 64 + n * 16 + fr) * 136 + wr * 64 + m * 16 + fq * 4) = v;
        }
    }
    __syncthreads();
    if (EPI != E_MQ) {
#pragma unroll
      for (int i = 0; i < 8; ++i) {
        int c = tid + 256 * i; int rr = c >> 4, c16 = c & 15;
        *(uint4*)(dst + (size_t)rr * ldd + c16 * 8) = *(const uint4*)(Cs + rr * 136 + c16 * 8);
      }
      __syncthreads();
    }
  } else if (EPI == E_RES1 || EPI == E_RES2) {
    const float* resid = (EPI == E_RES1) ? p->x : p->out;
    float* rowss = (EPI == E_RES1) ? p->rowss1 : p->rowss2;
    float* Cf = (float*)smem;
#pragma unroll
    for (int m = 0; m < 4; ++m)
#pragma unroll
      for (int n = 0; n < 4; ++n)
#pragma unroll
        for (int j = 0; j < 4; ++j) Cf[(wr * 64 + m * 16 + fq * 4 + j) * 132 + wc * 64 + n * 16 + fr] = acc[m][n][j];
    __syncthreads();
#pragma unroll 8
    for (int i = 0; i < 16; ++i) {
      const int row = (tid >> 5) + 8 * i, c4 = tid & 31;
      const float4 a = *(const float4*)(Cf + row * 132 + c4 * 4);
      const size_t grow = (size_t)(tm * 128 + row);
      const size_t g = grow * 2048 + tn * 128 + c4 * 4;
      const float4 r = *(const float4*)(resid + g);
      float4 v; v.x = r.x + a.x; v.y = r.y + a.y; v.z = r.z + a.z; v.w = r.w + a.w;
      *(float4*)(p->out + g) = v;
      uint2 pk; pk.x = pack2(v.x, v.y); pk.y = pack2(v.z, v.w);
      *(uint2*)(p->actb + grow * LD2K + tn * 128 + c4 * 4) = pk;
      float ss = v.x * v.x + v.y * v.y + v.z * v.z + v.w * v.w;
      ss += __shfl_xor(ss, 1); ss += __shfl_xor(ss, 2); ss += __shfl_xor(ss, 4); ss += __shfl_xor(ss, 8); ss += __shfl_xor(ss, 16);
      if (c4 == 0) atomicAdd(&rowss[grow], ss);
    }
    __syncthreads();
  } else if (EPI == E_GU) {
#pragma unroll
    for (int m = 0; m < 4; ++m)
#pragma unroll
      for (int j = 0; j < 4; ++j) {
        const int rl = wr * 64 + m * 16 + fq * 4 + j;
        float sr = rsqrtf(rsc[m][j] * (1.f / 2048.f) + 1e-6f);
#pragma unroll
        for (int ns = 0; ns < 2; ++ns) {
          float gv = acc[m][ns][j] * sr, uv = acc[m][ns + 2][j] * sr;
          Cs[rl * 72 + wc * 32 + ns * 16 + fr] = f2bf(gv * sigm(gv) * uv);
        }
      }
    __syncthreads();
    u16* dst = p->hidden + (size_t)(tm * 128) * LDH + tn * 64;
#pragma unroll
    for (int i = 0; i < 4; ++i) {
      int c = tid + 256 * i; int rr = c >> 3, c8 = c & 7;
      *(uint4*)(dst + (size_t)rr * LDH + c8 * 8) = *(const uint4*)(Cs + rr * 72 + c8 * 8);
    }
    __syncthreads();
  } else {
    float* Cf = (float*)smem;
#pragma unroll
    for (int m = 0; m < 4; ++m)
#pragma unroll
      for (int n = 0; n < 4; ++n)
#pragma unroll
        for (int j = 0; j < 4; ++j) Cf[(wr * 64 + m * 16 + fq * 4 + j) * 132 + wc * 64 + n * 16 + fr] = acc[m][n][j];
    __syncthreads();
#pragma unroll 8
    for (int i = 0; i < 16; ++i) {
      const int row = (tid >> 5) + 8 * i, c4 = tid & 31;
      const float4 a = *(const float4*)(Cf + row * 132 + c4 * 4);
      const size_t g = (size_t)(tm * 128 + row) * 2048 + tn * 128 + c4 * 4;
      const float4 r = *(const float4*)(p->out + g);
      float4 v; v.x = r.x + a.x; v.y = r.y + a.y; v.z = r.z + a.z; v.w = r.w + a.w;
      *(float4*)(p->out + g) = v;
    }
    __syncthreads();
  }
}

DI void mem_attn_tile(KP p, int tm, int hd, char* smem) {
  const int tid = otid(), lane = tid & 63, w = tid >> 6, r = lane & 31, h = lane >> 5;
  const u16* Cs = (const u16*)smem;
  bf16x8 qf[8];
#pragma unroll
  for (int ks = 0; ks < 8; ++ks) qf[ks] = lds128(Cs + (w * 32 + r) * 136 + ks * 16 + h * 8);
  u16* Ks = (u16*)smem;
  u16* VTs = Ks + 64 * 136;
  const int b = tm >> 4;
  const u16* kbase = p->memK + (size_t)(b * 256) * 512 + hd * 128;
  const u16* vbase = p->memVT + (size_t)((b * 4 + hd) * 128) * 256;
  f32x16 o[4];
#pragma unroll
  for (int db = 0; db < 4; ++db)
#pragma unroll
    for (int i = 0; i < 16; ++i) o[db][i] = 0.f;
  float m = -1e30f, l = 0.f;
  const float sc = 0.08838834764831845f * 1.44269504089f;
  for (int kb = 0; kb < 4; ++kb) {
    __syncthreads();
    stage_tile64(Ks, VTs, kbase + (size_t)(kb * 64) * 512, 512, vbase + kb * 64, 256);
    __syncthreads();
    flash_tile64<2, false>(o, m, l, qf, nullptr, Ks, VTs, kb * 64, 0, 0.f, sc, true, r, h);
  }
  float lt = l + __shfl_xor(l, 32);
  float f = rcpf_(lt);
  u16* dst = p->omem + (size_t)(tm * 128 + w * 32 + r) * LDO + hd * 128;
#pragma unroll
  for (int db = 0; db < 4; ++db)
#pragma unroll
    for (int i4 = 0; i4 < 4; ++i4) {
      uint2 v; v.x = pack2(o[db][4 * i4] * f, o[db][4 * i4 + 1] * f); v.y = pack2(o[db][4 * i4 + 2] * f, o[db][4 * i4 + 3] * f);
      *(uint2*)(dst + 32 * db + 8 * i4 + 4 * h) = v;
    }
  __syncthreads();
}

#define XB_TMO      128
#define XB_XCNT(j)  (256  + 64 * (j))
#define XB_XSUB(j)  (1280 + 64 * (j))
#define XB_XGEN(j)  (2304 + 64 * (j))
#define XB_TOP      3328
#define XB_TOPGEN   3392
#define XCD_BAR_WORDS 3456
#define XB_SPIN_CAP (1u << 18)
#define LAS __attribute__((address_space(3)))

__device__ __forceinline__ unsigned xb_ld(unsigned* p)              { return __hip_atomic_load(p, __ATOMIC_RELAXED, __HIP_MEMORY_SCOPE_AGENT); }
__device__ __forceinline__ unsigned xb_add(unsigned* p, unsigned v) { return __hip_atomic_fetch_add(p, v, __ATOMIC_RELAXED, __HIP_MEMORY_SCOPE_AGENT); }
__device__ __forceinline__ unsigned xb_xcc_id() { return (unsigned)__builtin_amdgcn_s_getreg((3 << 11) | 20) & 0xFu; }
#define XB_SPIN(cond, bar) do { unsigned _sp = 0; while (cond) { __builtin_amdgcn_s_sleep(1); \
    if ((++_sp & 255u) == 0u) { if (xb_ld(&(bar)[XB_TMO])) break; if (_sp > XB_SPIN_CAP) { atomicAdd(&(bar)[XB_TMO], 1u); break; } } } } while (0)

struct XcdBarrier {
    unsigned* bar; unsigned x;
    volatile LAS unsigned* st;
};

__device__ __forceinline__ XcdBarrier xcd_barrier_post(unsigned* bar, volatile LAS unsigned* st) {
    XcdBarrier b; b.bar = bar; b.x = xb_xcc_id(); b.st = st;
    if (threadIdx.x == 0) (void)xb_add(&bar[XB_XCNT(b.x)], 1u);
    return b;
}
__device__ __forceinline__ void xcd_barrier_complete(unsigned* bar, unsigned x, unsigned& nloc, unsigned& nx) {
    const unsigned G = gridDim.x * gridDim.y * gridDim.z;
    unsigned sum, cnt, mine, sp = 0u;
    for (;;) {
        sum = 0u; cnt = 0u; mine = 0u;
#pragma unroll
        for (unsigned j = 0; j < 16; ++j) { const unsigned c = xb_ld(&bar[XB_XCNT(j)]); sum += c; cnt += (c > 0u) ? 1u : 0u; mine = (j == x) ? c : mine; }
        if (sum == G) break;
        __builtin_amdgcn_s_sleep(1);
        if ((++sp & 255u) == 0u) { if (xb_ld(&bar[XB_TMO])) break; if (sp > XB_SPIN_CAP) { atomicAdd(&bar[XB_TMO], 1u); break; } }
    }
    nloc = mine > 0u ? mine : 1u; nx = cnt > 0u ? cnt : 1u;
}

__device__ __forceinline__ void xcd_barrier(const XcdBarrier& b) {
    asm volatile("s_waitcnt vmcnt(0)" ::: "memory");
    __syncthreads();
    if (threadIdx.x == 0) {
        unsigned* bar = b.bar;
        __builtin_amdgcn_s_waitcnt(0);
        unsigned nloc = b.st[0], nx = b.st[1];
        if (nloc == 0u) { xcd_barrier_complete(bar, b.x, nloc, nx); b.st[0] = nloc; b.st[1] = nx; }
        const unsigned old = xb_add(&bar[XB_XSUB(b.x)], 1u);
        const unsigned gen = old / nloc;
        if (old + 1u == (gen + 1u) * nloc) {
            __builtin_amdgcn_fence(__ATOMIC_RELEASE, "agent");
            asm volatile("s_waitcnt vmcnt(0)" ::: "memory");
            const unsigned og = xb_add(&bar[XB_TOP], 1u);
            const unsigned tg = og / nx;
            if (og + 1u == (tg + 1u) * nx) xb_add(&bar[XB_TOPGEN], 1u);
            else XB_SPIN(xb_ld(&bar[XB_TOPGEN]) == tg, bar);
            __builtin_amdgcn_fence(__ATOMIC_ACQUIRE, "agent");
            xb_add(&bar[XB_XGEN(b.x)], 1u);
            asm volatile("s_waitcnt vmcnt(0)" ::: "memory");
        } else {
            XB_SPIN(xb_ld(&bar[XB_XGEN(b.x)]) == gen, bar);
            __builtin_amdgcn_fence(__ATOMIC_ACQUIRE, "agent");
            asm volatile("s_waitcnt vmcnt(0)" ::: "memory");
        }
    }
    __syncthreads();
}


DI void p1_map(int v, int& tm, int& tn) {
  if (v < 2048) { int sbi = v >> 6, wi = v & 63; tm = (sbi & 7) * 8 + (wi & 7); tn = (sbi >> 3) * 8 + (wi >> 3); }
  else { int u = v - 2048; int grp = u / 40, wi = u - grp * 40; tm = grp * 8 + (wi & 7); tn = 32 + (wi >> 3); }
}
DI bool tile_map(int v, int NSM, int NTN, int& tm, int& tn) {
  int sbi = v >> 6, within = v & 63;
  int sm = within & 7, sn = within >> 3;
  int sbm = sbi % NSM, sbn = sbi / NSM;
  tm = sbm * 8 + sm; tn = sbn * 8 + sn;
  return tn < NTN;
}

__global__ void __launch_bounds__(256, 2) hymba_mega(Params p) {
  extern __shared__ __attribute__((aligned(16))) char smem[];
  cg::grid_group grid = cg::this_grid();
  __shared__ uint4 xb_words;
  if (threadIdx.x == 0) xb_words = make_uint4(0u, 0u, 0u, 0u);
  __syncthreads();
  XcdBarrier xb = xcd_barrier_post(p.bar, (volatile LAS unsigned*)&xb_words);
  const int G = gridDim.x, bid = blockIdx.x;
  const int vb = bid;
  for (int st = 0; st < p.nsteps; ++st) {
    const int ph = (int)((p.steps >> (4 * st)) & 15ull);
    if (st > 0) {
      if (p.use_cg) grid.sync();
      else { XcdBarrier xt = xb; xt.bar = (unsigned*)getp()->bar; xcd_barrier(xt); }
    }
    int tm, tn;
    KP kp = getp();
    switch (ph) {
#if !defined(ONLY) || ONLY == 0
      case 0: phase0(kp, smem); break;
#endif
#if !defined(ONLY) || ONLY == 1
      case 1: {

        for (int v = vb; v < 2368 + 64 + 64; v += G) {
          if (v < 2368) {
            p1_map(v, tm, tn);
            const int nv = v + G; const bool nx = nv < 2368; int tm2 = 0, tn2 = 0; if (nx) p1_map(nv, tm2, tn2);
            (void)nx; (void)tm2; (void)tn2;
            gemm_tile<E_IN>(kp, kp->actb, LD2K, kp->Wt_in, LD2K, 2048, tm, tn, smem);
          } else if (v < 2368 + 64) { int v2 = v - 2368; gemm_tile<E_MKV>(kp, kp->hm, LD2K, kp->Wt_mkv, LD2K, 2048, v2 & 7, v2 >> 3, smem); }
          else cbias_item(kp, v - 2432);
        }
      } break;
#endif
#if !defined(ONLY) || ONLY == 2
      case 2:
        if (G == 512) {
          if (bid < 128) { compress_item(kp, bid, smem); conv_item(kp, bid, smem); }
          else { for (int j = 0; j < 5; ++j) conv_item(kp, 128 + (bid - 128) + 384 * j, smem); }
        } else {
          for (int it = bid; it < 128 + 2048; it += G) { if (it < 2048) conv_item(kp, it, smem); else compress_item(kp, it - 2048, smem); }
        }
        break;
#endif
#if !defined(ONLY) || ONLY == 3
      case 3:
        for (int it = bid; it < 1024; it += G) { if (it < 512) nsa_item(kp, it, smem); else conv_fin_item(kp, it - 512); }
        break;
#endif
#if !defined(ONLY) || ONLY == 4
      case 4: {

        for (int v = vb; v < 1024; v += G) {
          tile_map(v, 8, 16, tm, tn);
          const int nv = v + G; const bool nx = nv < 1024; int tm2 = 0, tn2 = 0; if (nx) tile_map(nv, 8, 16, tm2, tn2);
          gemm_tile<E_RES1>(kp, kp->cat, LD2K, kp->Wt_out, LD2K, 2048, tm, tn, smem);
        }
      } break;
#endif
#if !defined(ONLY) || ONLY == 5
      case 5:
        for (int v = bid; v < 256; v += G) { tm = v & 63; tn = v >> 6; gemm_tile<E_MQ>(kp, kp->actb, LD2K, kp->Wt_mq, LD2K, 2048, tm, tn, smem); mem_attn_tile(kp, tm, tn, smem); }
        break;
#endif
#if !defined(ONLY) || ONLY == 6
      case 6: {

        for (int v = vb; v < 1024; v += G) {
          tile_map(v, 8, 16, tm, tn);
          const int nv = v + G; const bool nx = nv < 1024; int tm2 = 0, tn2 = 0; if (nx) tile_map(nv, 8, 16, tm2, tn2);
          gemm_tile<E_RES2>(kp, kp->omem, LDO, kp->Wt_mo, LDO, 512, tm, tn, smem);
        }
      } break;
#endif
#if !defined(ONLY) || ONLY == 7
      case 7: {

        for (int v = vb; v < 8 * 11 * 64; v += G) {
          tile_map(v, 8, 88, tm, tn);
          const int nv = v + G; const bool nx = nv < 8 * 11 * 64; int tm2 = 0, tn2 = 0; if (nx) tile_map(nv, 8, 88, tm2, tn2);
          gemm_tile<E_GU>(kp, kp->actb, LD2K, kp->Wt_gu, LD2K, 2048, tm, tn, smem);
        }
      } break;
#endif
#if !defined(ONLY) || ONLY == 8
      case 8: {

        for (int v = vb; v < 1024; v += G) {
          tile_map(v, 8, 16, tm, tn);
          const int nv = v + G; const bool nx = nv < 1024; int tm2 = 0, tn2 = 0; if (nx) tile_map(nv, 8, 16, tm2, tn2);
          gemm_tile<E_FIN>(kp, kp->hidden, LDH, kp->Wt_down, LDH, FH, tm, tn, smem);
        }
      } break;
#endif
    }
  }
}

extern "C" void kernel_launch(void* const* d_in, const int* in_sizes, int n_in, void* d_out, int out_size, void* d_ws,
                              size_t ws_size, hipStream_t stream) {
  static int grid_blocks = 0;
  if (!grid_blocks) {
    hipFuncSetAttribute((const void*)hymba_mega, hipFuncAttributeMaxDynamicSharedMemorySize, LDS_BYTES);
    int dev = 0, cus = 0, per_cu = 0;
    hipGetDevice(&dev);
    hipDeviceGetAttribute(&cus, hipDeviceAttributeMultiprocessorCount, dev);
    hipOccupancyMaxActiveBlocksPerMultiprocessor(&per_cu, hymba_mega, 256, LDS_BYTES);
    if (per_cu > 2) per_cu = 2;
    if (per_cu < 1) per_cu = 1;
    grid_blocks = cus * per_cu;
  }
  Params p;
  memset(&p, 0, sizeof(p));
  const float** fp = (const float**)&p;
  for (int i = 0; i < 32; ++i) fp[i] = (const float*)d_in[i];
  p.out = (float*)d_out;
  char* ws = (char*)d_ws;
  size_t off = 0;
  auto take = [&](size_t bytes) { char* r = ws + off; off += (bytes + 255) & ~(size_t)255; return r; };
  p.Wt_in = (u16*)take((size_t)ZW * LD2K * 2);
  p.Wt_mkv = (u16*)take((size_t)1024 * LD2K * 2);
  p.Wt_out = (u16*)take((size_t)2048 * LD2K * 2);
  p.Wt_mq = (u16*)take((size_t)512 * LD2K * 2);
  p.Wt_mo = (u16*)take((size_t)2048 * LDO * 2);
  p.Wt_gu = (u16*)take((size_t)2 * FH * LD2K * 2);
  p.Wt_down = (u16*)take((size_t)2048 * LDH * 2);
  p.Wt_ck1 = (u16*)take((size_t)128 * 4096 * 2);
  p.Wt_cv1 = (u16*)take((size_t)128 * 4096 * 2);
  p.Wt_ck2 = (u16*)take((size_t)128 * 128 * 2);
  p.Wt_cv2 = (u16*)take((size_t)128 * 128 * 2);
  p.actb = (u16*)take((size_t)8192 * LD2K * 2);
  p.ybuf = (float*)p.actb;
  p.hm = (u16*)take((size_t)1024 * LD2K * 2);
  char* region = take((size_t)8192 * ZW * 2 + (size_t)8192 * LD2K * 2);
  p.z = (u16*)region;
  p.cat = (u16*)(region + (size_t)8192 * ZW * 2);
  p.hidden = (u16*)region;
  p.omem = (u16*)take((size_t)8192 * LDO * 2);
  p.memK = (u16*)take((size_t)1024 * 512 * 2);
  p.memVT = (u16*)take((size_t)1024 * 512 * 2);
  p.kcmp = (u16*)take((size_t)8 * 128 * 128 * 2);
  p.vcmpT = (u16*)take((size_t)8 * 128 * 128 * 2);
  p.vslT = (u16*)take((size_t)8 * 128 * 2048 * 2);
  p.vwT = (u16*)take((size_t)8 * 128 * 2048 * 2);
  p.rowss1 = (float*)take(8192 * 4);
  p.rowss2 = (float*)take(8192 * 4);
  p.cstats = (float*)take(8192 * 2 * 4);
  p.bar = (unsigned*)take(XCD_BAR_WORDS * 4);
  p.cbias = (float*)take(256 * 4);
  if (off > ws_size) { fprintf(stderr, "workspace too small: need %zu have %zu\n", off, ws_size); return; }
  hipMemsetAsync(p.bar, 0, XCD_BAR_WORDS * 4, stream);
#if COOP
  p.steps = STEPS; p.nsteps = NSTEPS; p.use_cg = 0;
  void* args[] = {&p};
  hipError_t e = hipLaunchCooperativeKernel((const void*)hymba_mega, dim3(grid_blocks), dim3(256), args, LDS_BYTES, stream);
  if (e != hipSuccess) fprintf(stderr, "cooperative launch failed: %s (grid %d)\n", hipGetErrorString(e), grid_blocks);
#else
  for (int ph = 0; ph < NPHASE; ++ph) {
    p.steps = (unsigned long long)ph; p.nsteps = 1;
    hipLaunchKernelGGL(hymba_mega, dim3(grid_blocks), dim3(256), LDS_BYTES, stream, p);
  }
#endif
}
```

```cpp
#include <hip/hip_runtime.h>
#include <hip/hip_cooperative_groups.h>
#include <cstdio>
#include <cstring>
namespace cg = cooperative_groups;

#ifndef COOP
#define COOP 1
#endif
#define STEPS 0x876543210ull
#define NSTEPS 9

typedef unsigned short u16;
using bf16x8 = __attribute__((ext_vector_type(8))) short;
using s16x4  = __attribute__((ext_vector_type(4))) short;
using f32x4  = __attribute__((ext_vector_type(4))) float;
using f32x16 = __attribute__((ext_vector_type(16))) float;
using u32x4  = __attribute__((ext_vector_type(4))) unsigned;
typedef __attribute__((ext_vector_type(2))) __bf16 bf2_t;
#define DI __device__ __forceinline__
#define MFMA16(a, b, c) __builtin_amdgcn_mfma_f32_16x16x32_bf16((a), (b), (c), 0, 0, 0)
#define MFMA32(a, b, c) __builtin_amdgcn_mfma_f32_32x32x16_bf16((a), (b), (c), 0, 0, 0)
#define EXP2(x) __builtin_amdgcn_exp2f(x)

constexpr int ZW = 4736;
constexpr int FH = 5632;
constexpr int LD2K = 2048 + 64;
constexpr int LDH = 5632 + 64;
constexpr int LDO = 512 + 64;
constexpr int LDS_BYTES = 73728;
constexpr int NPHASE = 9;

struct Params {
  const float *x, *mem, *norm_mix, *w_in, *gate_b, *q_norm, *k_norm_cmp, *k_norm_slc, *k_norm_win,
      *cmp_pos_k, *cmp_pos_v, *cmp_k_w1, *cmp_k_w2, *cmp_v_w1, *cmp_v_w2, *conv_w, *conv_b, *conv_ln_g, *conv_ln_b,
      *w_out, *norm_mem_q, *norm_mem_kv, *w_mq, *w_mk, *w_mv, *mq_norm, *mk_norm, *w_mo, *norm_ffn, *w_gate, *w_up, *w_down;
  float* out;
  u16 *Wt_in, *Wt_mkv, *Wt_out, *Wt_mq, *Wt_mo, *Wt_gu, *Wt_down, *Wt_ck1, *Wt_cv1, *Wt_ck2, *Wt_cv2;
  u16 *actb, *hm, *z, *cat, *hidden, *memK, *memVT, *kcmp, *vcmpT, *vslT, *vwT, *omem;
  float *ybuf, *rowss1, *rowss2, *cstats, *cbias;
  unsigned* bar;
  unsigned long long steps;
  int nsteps, use_cg;
};

typedef const __attribute__((address_space(4))) Params* KP;
DI KP getp() { KP q = (KP)__builtin_amdgcn_kernarg_segment_ptr(); asm volatile("" : "+s"(q)); return q; }

DI int otid() { int t = threadIdx.x; asm volatile("" : "+v"(t)); return t; }
DI float bf2f(u16 v) { return __uint_as_float(((unsigned)v) << 16); }
DI unsigned pack2(float a, float b) { bf2_t v; v[0] = (__bf16)a; v[1] = (__bf16)b; return __builtin_bit_cast(unsigned, v); }
DI u16 f2bf(float a) { return (u16)(pack2(a, 0.f) & 0xffffu); }
DI float rcpf_(float x) { return __builtin_amdgcn_rcpf(x); }
DI float sigm(float x) { return rcpf_(1.f + __expf(-x)); }
DI void lds_barrier() { asm volatile("s_waitcnt lgkmcnt(0)\n\ts_barrier" ::: "memory"); }
DI bf16x8 lds128(const u16* p) { return *reinterpret_cast<const bf16x8*>(p); }

template <int NT>
DI void transpose_tile(const float* __restrict__ src, u16* __restrict__ dst, const float* __restrict__ ks, int K, int N,
                       int mode, int tile, char* smem, int ldd) {
  const int tid = otid();
  const int KT = (K >> 6) / NT;
  const int k0 = (tile % KT) * 64 * NT, n0 = (tile / KT) * 64;
  u16* t = (u16*)smem;
  const int kq = tid >> 4, nq = tid & 15;
  float4 v[NT][4];
#pragma unroll
  for (int q = 0; q < NT; ++q)
#pragma unroll
    for (int r = 0; r < 4; ++r) {
      v[q][r] = make_float4(0.f, 0.f, 0.f, 0.f);
      if (n0 + nq * 4 < N) v[q][r] = *(const float4*)(src + (size_t)(k0 + q * 64 + kq * 4 + r) * N + n0 + nq * 4);
    }
#pragma unroll
  for (int q = 0; q < NT; ++q) {
    if (ks) {
      float4 s = *(const float4*)(ks + k0 + q * 64 + kq * 4);
      v[q][0].x *= s.x; v[q][0].y *= s.x; v[q][0].z *= s.x; v[q][0].w *= s.x;
      v[q][1].x *= s.y; v[q][1].y *= s.y; v[q][1].z *= s.y; v[q][1].w *= s.y;
      v[q][2].x *= s.z; v[q][2].y *= s.z; v[q][2].z *= s.z; v[q][2].w *= s.z;
      v[q][3].x *= s.w; v[q][3].y *= s.w; v[q][3].z *= s.w; v[q][3].w *= s.w;
    }
    __syncthreads();
    {
      uint2 w0, w1, w2, w3;
      w0.x = pack2(v[q][0].x, v[q][1].x); w0.y = pack2(v[q][2].x, v[q][3].x);
      w1.x = pack2(v[q][0].y, v[q][1].y); w1.y = pack2(v[q][2].y, v[q][3].y);
      w2.x = pack2(v[q][0].z, v[q][1].z); w2.y = pack2(v[q][2].z, v[q][3].z);
      w3.x = pack2(v[q][0].w, v[q][1].w); w3.y = pack2(v[q][2].w, v[q][3].w);
      *(uint2*)(t + (nq * 4 + 0) * 72 + kq * 4) = w0;
      *(uint2*)(t + (nq * 4 + 1) * 72 + kq * 4) = w1;
      *(uint2*)(t + (nq * 4 + 2) * 72 + kq * 4) = w2;
      *(uint2*)(t + (nq * 4 + 3) * 72 + kq * 4) = w3;
    }
    __syncthreads();
#pragma unroll
    for (int pass = 0; pass < 2; ++pass) {
      int nn = pass * 32 + (tid >> 3), kc = (tid & 7) * 8;
      uint4 o = *(const uint4*)(t + nn * 72 + kc);
      int n = n0 + nn;
      int drow = n;
      if (mode == 1) drow = (n >> 5) * 64 + (n & 31);
      if (mode == 2) drow = (n >> 5) * 64 + 32 + (n & 31);
      *(uint4*)(dst + (size_t)drow * ldd + k0 + q * 64 + kc) = o;
    }
  }
}

DI void norm_rows_item(KP p, int item) {
  const int lane = otid() & 63, w = otid() >> 6;
  const int row0 = item * 8 + w * 2;
  const float* src; const float* gain; u16* dst;
  if (row0 < 8192) { src = p->x + (size_t)row0 * 2048; gain = p->norm_mix; dst = p->actb + (size_t)row0 * LD2K; }
  else { src = p->mem + (size_t)(row0 - 8192) * 2048; gain = p->norm_mem_kv; dst = p->hm + (size_t)(row0 - 8192) * LD2K; }
  float4 v0[8], v1[8], g[8];
#pragma unroll
  for (int i = 0; i < 8; ++i) { v0[i] = *(const float4*)(src + (i * 64 + lane) * 4); v1[i] = *(const float4*)(src + 2048 + (i * 64 + lane) * 4); }
#pragma unroll
  for (int i = 0; i < 8; ++i) g[i] = *(const float4*)(gain + (i * 64 + lane) * 4);
  float s0 = 0.f, s1 = 0.f;
#pragma unroll
  for (int i = 0; i < 8; ++i) {
    s0 += v0[i].x * v0[i].x + v0[i].y * v0[i].y + v0[i].z * v0[i].z + v0[i].w * v0[i].w;
    s1 += v1[i].x * v1[i].x + v1[i].y * v1[i].y + v1[i].z * v1[i].z + v1[i].w * v1[i].w;
  }
#pragma unroll
  for (int o = 32; o >= 1; o >>= 1) { s0 += __shfl_xor(s0, o); s1 += __shfl_xor(s1, o); }
  const float r0 = rsqrtf(s0 * (1.f / 2048.f) + 1e-6f), r1 = rsqrtf(s1 * (1.f / 2048.f) + 1e-6f);
#pragma unroll
  for (int i = 0; i < 8; ++i) {
    uint2 o0, o1;
    o0.x = pack2(v0[i].x * r0 * g[i].x, v0[i].y * r0 * g[i].y); o0.y = pack2(v0[i].z * r0 * g[i].z, v0[i].w * r0 * g[i].w);
    o1.x = pack2(v1[i].x * r1 * g[i].x, v1[i].y * r1 * g[i].y); o1.y = pack2(v1[i].z * r1 * g[i].z, v1[i].w * r1 * g[i].w);
    *(uint2*)(dst + (i * 64 + lane) * 4) = o0;
    *(uint2*)(dst + LD2K + (i * 64 + lane) * 4) = o1;
  }
}

DI void phase0(KP p, char* smem) {
  const int G = gridDim.x, bid = blockIdx.x;
  constexpr int C0 = 296, C1 = C0 + 32, C2 = C1 + 32, C3 = C2 + 128, C4 = C3 + 32, C5 = C4 + 32, C6 = C5 + 352,
                C7 = C6 + 352, C8 = C7 + 352, C9 = C8 + 16, C10 = C9 + 16, C11 = C10 + 4, C12 = C11 + 4;
  constexpr int NNORM = 1152, NZ = 1;
  const int total = C12 + NNORM + NZ;
  for (int it = bid; it < total; it += G) {
    if (it < C12) {
      if (it < C0) transpose_tile<8>(p->w_in, p->Wt_in, nullptr, 2048, 4632, 0, it, smem, LD2K);
      else if (it < C1) transpose_tile<8>(p->w_mk, p->Wt_mkv, nullptr, 2048, 512, 0, it - C0, smem, LD2K);
      else if (it < C2) transpose_tile<8>(p->w_mv, p->Wt_mkv + (size_t)512 * LD2K, nullptr, 2048, 512, 0, it - C1, smem, LD2K);
      else if (it < C3) transpose_tile<8>(p->w_out, p->Wt_out, nullptr, 2048, 2048, 0, it - C2, smem, LD2K);
      else if (it < C4) transpose_tile<8>(p->w_mq, p->Wt_mq, p->norm_mem_q, 2048, 512, 0, it - C3, smem, LD2K);
      else if (it < C5) transpose_tile<8>(p->w_mo, p->Wt_mo, nullptr, 512, 2048, 0, it - C4, smem, LDO);
      else if (it < C6) transpose_tile<8>(p->w_gate, p->Wt_gu, p->norm_ffn, 2048, 5632, 1, it - C5, smem, LD2K);
      else if (it < C7) transpose_tile<8>(p->w_up, p->Wt_gu, p->norm_ffn, 2048, 5632, 2, it - C6, smem, LD2K);
      else if (it < C8) transpose_tile<8>(p->w_down, p->Wt_down, nullptr, 5632, 2048, 0, it - C7, smem, LDH);
      else if (it < C9) transpose_tile<8>(p->cmp_k_w1, p->Wt_ck1, nullptr, 4096, 128, 0, it - C8, smem, 4096);
      else if (it < C10) transpose_tile<8>(p->cmp_v_w1, p->Wt_cv1, nullptr, 4096, 128, 0, it - C9, smem, 4096);
      else if (it < C11) transpose_tile<1>(p->cmp_k_w2, p->Wt_ck2, nullptr, 128, 128, 0, it - C10, smem, 128);
      else transpose_tile<1>(p->cmp_v_w2, p->Wt_cv2, nullptr, 128, 128, 0, it - C11, smem, 128);
    } else if (it < C12 + NNORM) {
      norm_rows_item(p, it - C12);
    } else {
      for (int i = otid(); i < 8192; i += 256) { p->rowss1[i] = 0.f; p->rowss2[i] = 0.f; p->cstats[2 * i] = 0.f; p->cstats[2 * i + 1] = 0.f; }
    }
  }
}

DI bf16x8 pack8(const f32x16& s, int s2) {
  unsigned a = pack2(s[8 * s2 + 0], s[8 * s2 + 1]);
  unsigned b = pack2(s[8 * s2 + 2], s[8 * s2 + 3]);
  unsigned c = pack2(s[8 * s2 + 4], s[8 * s2 + 5]);
  unsigned d = pack2(s[8 * s2 + 6], s[8 * s2 + 7]);
  uint4 u = make_uint4(a, b, c, d);
  return __builtin_bit_cast(bf16x8, u);
}
DI bf16x8 ldvt(const u16* base) {
  s16x4 lo = *(const s16x4*)(base);
  s16x4 hi = *(const s16x4*)(base + 8);
  return __builtin_shufflevector(lo, hi, 0, 1, 2, 3, 4, 5, 6, 7);
}

template <int MODE, bool QLDS, bool SWZ = false>
DI void flash_tile64(f32x16 (&o)[4], float& m, float& l, const bf16x8 (&qf)[8], const u16* qs, const u16* Ks, const u16* VTs,
                     int key0, int t, float slope, float sc, bool sel, int r, int h, unsigned wlim = 0x80000000u) {
#pragma unroll 1
  for (int sub = 0; sub < 2; ++sub) {
    f32x16 s;
#pragma unroll
    for (int i = 0; i < 16; ++i) s[i] = 0.f;
    if (QLDS) {
#pragma unroll 2
      for (int ks = 0; ks < 8; ++ks) {
        bf16x8 a = lds128(Ks + (sub * 32 + r) * 136 + ks * 16 + h * 8);
        bf16x8 q = lds128(qs + ks * 16);
        s = MFMA32(a, q, s);
      }
    } else {
#pragma unroll
      for (int ks = 0; ks < 8; ++ks) {
        bf16x8 a = SWZ ? lds128(Ks + (sub * 32 + r) * 128 + (((ks * 2 + h) ^ (r & 15)) * 8))
                       : lds128(Ks + (sub * 32 + r) * 136 + ks * 16 + h * 8);
        s = MFMA32(a, qf[ks], s);
      }
    }
    float mx = -1e30f;
    const int rel = t - key0 - sub * 32 - 4 * h;
    const float nbase = -slope * (float)rel;
#pragma unroll
    for (int i = 0; i < 16; ++i) {
      const int ci = (i & 3) + 8 * (i >> 2);
      float v = s[i] * sc;
      if (MODE != 2) v = fmaf(slope, (float)ci, v + nbase);
      if (MODE == 0) { bool ok = sel && ((unsigned)(rel - ci) < wlim); v = ok ? v : -1e30f; }
      s[i] = v;
      mx = fmaxf(mx, v);
      if ((i & 3) == 3) __builtin_amdgcn_sched_barrier(0);
    }
    mx = fmaxf(mx, __shfl_xor(mx, 32));
    float mn = fmaxf(m, mx);
    float alpha = EXP2(m - mn);
    float ps = 0.f;
#pragma unroll
    for (int i = 0; i < 16; ++i) {
      float pv = EXP2(s[i] - mn);
      if (MODE != 2) pv = (s[i] > -1e29f) ? pv : 0.f;
      s[i] = pv;
      ps += pv;
      if ((i & 3) == 3) __builtin_amdgcn_sched_barrier(0);
    }
    l = l * alpha + ps;
    m = mn;
#pragma unroll
    for (int db = 0; db < 4; ++db)
#pragma unroll
      for (int i = 0; i < 16; ++i) o[db][i] *= alpha;
#pragma unroll
    for (int s2 = 0; s2 < 2; ++s2) {
      bf16x8 P = pack8(s, s2);
#pragma unroll
      for (int db = 0; db < 4; ++db) {
        bf16x8 a;
        if (SWZ) {
          const int d = 32 * db + r, sw = (d & 7) ^ ((d >> 3) & 7), ch = sub * 4 + s2 * 2;
          s16x4 lo = *(const s16x4*)(VTs + d * 64 + ((ch ^ sw) * 8) + h * 4);
          s16x4 hi = *(const s16x4*)(VTs + d * 64 + (((ch + 1) ^ sw) * 8) + h * 4);
          a = __builtin_shufflevector(lo, hi, 0, 1, 2, 3, 4, 5, 6, 7);
        } else {
          a = ldvt(VTs + (32 * db + r) * 72 + sub * 32 + 16 * s2 + 4 * h);
        }
        o[db] = MFMA32(a, P, o[db]);
      }
    }
  }
}

DI void stage_tile64(u16* Ks, u16* VTs, const u16* __restrict__ kg, int ldk, const u16* __restrict__ vg, int ldv) {
  const int tid = otid();
  uint4 a[4], b[4];
#pragma unroll
  for (int i = 0; i < 4; ++i) { int c = tid + 256 * i; int key = c >> 4, dc = c & 15; a[i] = *(const uint4*)(kg + (size_t)key * ldk + dc * 8); }
#pragma unroll
  for (int i = 0; i < 4; ++i) { int c = tid + 256 * i; int d = c >> 3, kc = c & 7; b[i] = *(const uint4*)(vg + (size_t)d * ldv + kc * 8); }
#pragma unroll
  for (int i = 0; i < 4; ++i) { int c = tid + 256 * i; int key = c >> 4, dc = c & 15; *(uint4*)(Ks + key * 136 + dc * 8) = a[i]; }
#pragma unroll
  for (int i = 0; i < 4; ++i) { int c = tid + 256 * i; int d = c >> 3, kc = c & 7; *(uint4*)(VTs + d * 72 + kc * 8) = b[i]; }
}

DI void tile_gload(u32x4 (&a)[4], u32x4 (&b)[4], const u16* __restrict__ kg, int ldk, const u16* __restrict__ vg, int ldv, int tid) {
  const unsigned koff = (unsigned)(((tid >> 4) * ldk + (tid & 15) * 8) * 2);
  const unsigned voff = (unsigned)(((tid >> 3) * ldv + (tid & 7) * 8) * 2);
#pragma unroll
  for (int i = 0; i < 4; ++i) a[i] = *(const u32x4*)((const char*)(kg + (size_t)(16 * i) * ldk) + koff);
#pragma unroll
  for (int i = 0; i < 4; ++i) b[i] = *(const u32x4*)((const char*)(vg + (size_t)(32 * i) * ldv) + voff);
}
DI void nsa_dma(const u16* __restrict__ kg, const u16* __restrict__ vg, u16* Kd, u16* Vd, int tid) {
  const int kr = tid >> 4, ksrc = ((tid & 15) ^ (kr & 15)) * 8;
#pragma unroll
  for (int i = 0; i < 4; ++i)
    __builtin_amdgcn_global_load_lds((const unsigned*)(kg + (size_t)(kr + 16 * i) * ZW + ksrc), (unsigned*)(Kd + tid * 8 + i * 2048), 16, 0, 0);
  const int vr = tid >> 3, vp = tid & 7;
#pragma unroll
  for (int i = 0; i < 4; ++i) {
    const int d = vr + 32 * i, sw = (d & 7) ^ ((d >> 3) & 7);
    __builtin_amdgcn_global_load_lds((const unsigned*)(vg + (size_t)d * 2048 + ((vp ^ sw) * 8)), (unsigned*)(Vd + tid * 8 + i * 2048), 16, 0, 0);
  }
}
DI void tile_lstore(u16* Ks, u16* VTs, const u32x4 (&a)[4], const u32x4 (&b)[4], int tid) {
#pragma unroll
  for (int i = 0; i < 4; ++i) { int c = tid + 256 * i; int key = c >> 4, dc = c & 15; *(u32x4*)(Ks + key * 136 + dc * 8) = a[i]; }
#pragma unroll
  for (int i = 0; i < 4; ++i) { int c = tid + 256 * i; int d = c >> 3, kc = c & 7; *(u32x4*)(VTs + d * 72 + kc * 8) = b[i]; }
}

DI void nsa_item(KP p, int item, char* smem) {
  const int tid = otid(), lane = tid & 63, w = tid >> 6, r = lane & 31, h = lane >> 5;
  const int tq = 63 - (item >> 3), g = item & 1, b = (item >> 1) & 3;
  const int t0 = tq * 32, qi = r >> 2, hg = r & 3, t = t0 + w * 8 + qi, head = g * 4 + hg;
  const size_t zrow = (size_t)(b * 2048 + t) * ZW;
  bf16x8 qf[8];
#pragma unroll
  for (int ks = 0; ks < 8; ++ks) qf[ks] = *(const bf16x8*)(p->z + zrow + head * 128 + ks * 16 + h * 8);
  const float L2E = 1.44269504089f;
  const float sc = 0.08838834764831845f * L2E;
  const float slope = EXP2(-(float)(head + 1)) * L2E;
#define NSA_GATE(br) sigm(bf2f(p->z[(size_t)(b * 2048 + t) * ZW + 2560 + head * 3 + (br)]) + p->gate_b[head * 3 + (br)])

  u16* Kc = (u16*)smem;
  u16* VTc = Kc + 128 * 136;
  unsigned* maskS = (unsigned*)(smem + 73600);
  u16* Qs = (u16*)(smem + 35840);
  float* impS = (float*)smem;
  u16* Ks = (u16*)smem;
  u16* VTs = Ks + 64 * 136;

  {
    const u16* kcg = p->kcmp + (size_t)(b * 2 + g) * 128 * 128;
    const u16* vcg = p->vcmpT + (size_t)(b * 2 + g) * 128 * 128;
    __syncthreads();
#pragma unroll 2
    for (int i = 0; i < 8; ++i) {
      int c = tid + 256 * i; int row = c >> 4, c16 = c & 15;
      *(uint4*)(Kc + row * 136 + c16 * 8) = *(const uint4*)(kcg + row * 128 + c16 * 8);
      *(uint4*)(VTc + row * 136 + c16 * 8) = *(const uint4*)(vcg + row * 128 + c16 * 8);
    }
    if (tid < 32) maskS[tid] = 0u;
    __syncthreads();
  }
#define NSA_OB (p->out + (size_t)(b * 2048 + t) * 2048 + head * 128 + 4 * h)
  {
    float mx = -1e30f, lsum = 0.f;
#pragma unroll 1
    for (int kt = 0; kt < 4; ++kt) {
      f32x16 s;
#pragma unroll
      for (int i = 0; i < 16; ++i) s[i] = 0.f;
#pragma unroll
      for (int ks = 0; ks < 8; ++ks) {
        bf16x8 a = lds128(Kc + (kt * 32 + r) * 136 + ks * 16 + h * 8);
        s = MFMA32(a, qf[ks], s);
      }
      float tmx = -1e30f;
      const int relc = t - 64 * h - 512 * kt;
      const float nb = -slope * ((float)relc - 15.5f);
#pragma unroll
      for (int i = 0; i < 16; ++i) {
        const int ci = (i & 3) + 8 * (i >> 2);
        bool ok = (relc >= 16 * ci + 31);
        float v = fmaf(slope, (float)(16 * ci), fmaf(s[i], sc, nb));
        v = ok ? v : -1e30f;
        s[i] = v;
        tmx = fmaxf(tmx, v);
      }
      tmx = fmaxf(tmx, __shfl_xor(tmx, 32));
      float mn = fmaxf(mx, tmx);
      float ps = 0.f;
#pragma unroll
      for (int i = 0; i < 16; ++i) ps += (s[i] > -1e29f) ? EXP2(s[i] - mn) : 0.f;
      lsum = lsum * EXP2(mx - mn) + ps;
      mx = mn;
    }
    lsum += __shfl_xor(lsum, 32);
    const float inv = lsum > 0.f ? rcpf_(lsum) : 0.f;
    float imp[16];
    float carry_in = 0.f;
    f32x16 o[4];
#pragma unroll
    for (int db = 0; db < 4; ++db)
#pragma unroll
      for (int i = 0; i < 16; ++i) o[db][i] = 0.f;
#pragma unroll
    for (int kt = 0; kt < 4; ++kt) {
      f32x16 s;
#pragma unroll
      for (int i = 0; i < 16; ++i) s[i] = 0.f;
#pragma unroll
      for (int ks = 0; ks < 8; ++ks) {
        bf16x8 a = lds128(Kc + (kt * 32 + r) * 136 + ks * 16 + h * 8);
        s = MFMA32(a, qf[ks], s);
      }
      const int relc = t - 64 * h - 512 * kt;
      const float nb = -slope * ((float)relc - 15.5f) - mx;
#pragma unroll
      for (int i = 0; i < 16; ++i) {
        const int ci = (i & 3) + 8 * (i >> 2);
        bool ok = (relc >= 16 * ci + 31);
        float v = fmaf(slope, (float)(16 * ci), fmaf(s[i], sc, nb));
        s[i] = ok ? EXP2(v) * inv : 0.f;
      }
#pragma unroll
      for (int b4 = 0; b4 < 4; ++b4) {
        float p0 = s[4 * b4], p1 = s[4 * b4 + 1], p2 = s[4 * b4 + 2], p3 = s[4 * b4 + 3];
        float rc = __shfl_xor(0.5f * p3, 32);
        imp[kt * 4 + b4] = p0 + p1 + p2 + 0.5f * p3 + (h ? rc : carry_in);
        carry_in = rc;
      }
      __builtin_amdgcn_sched_barrier(0);
#pragma unroll
      for (int s2 = 0; s2 < 2; ++s2) {
        bf16x8 P = pack8(s, s2);
#pragma unroll
        for (int db = 0; db < 4; ++db) {
          bf16x8 a = ldvt(VTc + (32 * db + r) * 136 + kt * 32 + 16 * s2 + 4 * h);
          o[db] = MFMA32(a, P, o[db]);
        }
        __builtin_amdgcn_sched_barrier(0);
      }
    }
    const float g0 = NSA_GATE(0);
#pragma unroll
    for (int db = 0; db < 4; ++db)
#pragma unroll
      for (int i4 = 0; i4 < 4; ++i4)
        *(float4*)(NSA_OB + 32 * db + 8 * i4) = make_float4(g0 * o[db][4 * i4], g0 * o[db][4 * i4 + 1], g0 * o[db][4 * i4 + 2], g0 * o[db][4 * i4 + 3]);
#pragma unroll
    for (int i = 0; i < 16; ++i) { imp[i] += __shfl_xor(imp[i], 1); imp[i] += __shfl_xor(imp[i], 2); }
    __syncthreads();
    if (hg == 0) {
#pragma unroll
      for (int i = 0; i < 16; ++i) impS[(w * 8 + qi) * 32 + 2 * i + h] = imp[i];
    }
    __syncthreads();
    {
      const int ql = tid >> 3, part = tid & 7;
      const int tqq = t0 + ql, cur = tqq >> 6;
      float scs[32];
#pragma unroll
      for (int j = 0; j < 32; ++j) {
        float v = impS[ql * 32 + j];
        bool valid = (j * 64 <= tqq);
        bool forced = (j == 0) || (j == cur) || (j == cur - 1);
        scs[j] = valid ? v + (forced ? 1000.f : 0.f) : -1e30f;
      }
      unsigned mb = 0u;
#pragma unroll
      for (int ii = 0; ii < 4; ++ii) {
        const int ci = part * 4 + ii;
        float v = impS[ql * 32 + ci];
        bool valid = (ci * 64 <= tqq);
        bool forced = (ci == 0) || (ci == cur) || (ci == cur - 1);
        float si = valid ? v + (forced ? 1000.f : 0.f) : -1e30f;
        int rank = 0;
#pragma unroll
        for (int j = 0; j < 32; ++j) rank += ((scs[j] > si) || (scs[j] == si && j < ci)) ? 1 : 0;
        if (rank < 16) mb |= (1u << ci);
      }
      atomicOr(&maskS[ql], mb);
    }
    __syncthreads();
  }
  unsigned mymask = maskS[w * 8 + qi];
  unsigned uni = 0u;
#pragma unroll
  for (int j = 0; j < 32; ++j) uni |= maskS[j];
  uni = __builtin_amdgcn_readfirstlane(uni);

  {
    f32x16 o[4];
#pragma unroll
    for (int db = 0; db < 4; ++db)
#pragma unroll
      for (int i = 0; i < 16; ++i) o[db][i] = 0.f;
    float m = -1e30f, l = 0.f;
    const int cmax = (t0 + 31) >> 6;
    const unsigned uni_c = uni & (cmax >= 31 ? 0xffffffffu : ((2u << cmax) - 1u));
    const int n_slc = __popc(uni_c);
    int lo = t0 - 511; lo = lo < 0 ? 0 : lo; lo >>= 6;
    const int total = n_slc + (cmax - lo + 1);
    const u16* kb_s = p->z + (size_t)(b * 2048) * ZW + 1536 + g * 128;
    const u16* vb_s = p->vslT + (size_t)(b * 2 + g) * 128 * 2048;
    const u16* kb_w = p->z + (size_t)(b * 2048) * ZW + 2048 + g * 128;
    const u16* vb_w = p->vwT + (size_t)(b * 2 + g) * 128 * 2048;
    unsigned rem = uni_c;
    u16* Kb0 = (u16*)smem;            u16* Vb0 = Kb0 + 8192;
    u16* Kb1 = Kb0 + 16384;           u16* Vb1 = Kb1 + 8192;
    int blk_nxt = __ffs(rem) - 1; rem &= rem - 1u;
    nsa_dma(kb_s + (size_t)(blk_nxt * 64) * ZW, vb_s + blk_nxt * 64, Kb0, Vb0, tid);
    for (int i = 0; i < total; ++i) {
      const int blk = blk_nxt;
      asm volatile("s_waitcnt vmcnt(0)" ::: "memory");
      __syncthreads();
      const u16* Ks = (i & 1) ? Kb1 : Kb0;
      const u16* VTs = (i & 1) ? Vb1 : Vb0;
      if (i + 1 < total) {
        u16* Kn = (i & 1) ? Kb0 : Kb1;
        u16* Vn = (i & 1) ? Vb0 : Vb1;
        if (i + 1 < n_slc) {
          blk_nxt = __builtin_amdgcn_readfirstlane(__ffs(rem) - 1); rem &= rem - 1u;
          nsa_dma(kb_s + (size_t)(blk_nxt * 64) * ZW, vb_s + blk_nxt * 64, Kn, Vn, tid);
        } else {
          blk_nxt = lo + (i + 1 - n_slc);
          nsa_dma(kb_w + (size_t)(blk_nxt * 64) * ZW, vb_w + blk_nxt * 64, Kn, Vn, tid);
        }
      }
      {
        const bool is_slc = i < n_slc;
        const bool sel = is_slc ? ((((mymask >> blk) & 1u) != 0u) && (blk * 64 <= t)) : true;
        if (__ballot(sel) != 0ull) flash_tile64<0, false, true>(o, m, l, qf, nullptr, Ks, VTs, blk * 64, t, slope, sc, sel, r, h, is_slc ? 0x80000000u : 512u);
        if (i == n_slc - 1) {
          float lt = l + __shfl_xor(l, 32);
          float f = NSA_GATE(1) * (lt > 0.f ? rcpf_(lt) : 0.f);
#pragma unroll
          for (int db = 0; db < 4; ++db)
#pragma unroll
            for (int i4 = 0; i4 < 4; ++i4) {
              float4 pv = *(const float4*)(NSA_OB + 32 * db + 8 * i4);
              pv.x += f * o[db][4 * i4]; pv.y += f * o[db][4 * i4 + 1]; pv.z += f * o[db][4 * i4 + 2]; pv.w += f * o[db][4 * i4 + 3];
              *(float4*)(NSA_OB + 32 * db + 8 * i4) = pv;
              if (i4 == 3) __builtin_amdgcn_sched_barrier(0);
            }
#pragma unroll
          for (int db = 0; db < 4; ++db)
#pragma unroll
            for (int q = 0; q < 16; ++q) o[db][q] = 0.f;
          m = -1e30f; l = 0.f;
        }
      }
    }
    float lt = l + __shfl_xor(l, 32);
    float f = NSA_GATE(2) * (lt > 0.f ? rcpf_(lt) : 0.f);
    u16* dst = p->cat + (size_t)(b * 2048 + t) * LD2K + head * 128;
#pragma unroll
    for (int db = 0; db < 4; ++db)
#pragma unroll
      for (int i4 = 0; i4 < 4; ++i4) {
        float4 pv = *(const float4*)(NSA_OB + 32 * db + 8 * i4);
        pv.x += f * o[db][4 * i4]; pv.y += f * o[db][4 * i4 + 1]; pv.z += f * o[db][4 * i4 + 2]; pv.w += f * o[db][4 * i4 + 3];
        uint2 v; v.x = pack2(pv.x, pv.y); v.y = pack2(pv.z, pv.w);
        *(uint2*)(dst + 32 * db + 8 * i4 + 4 * h) = v;
        if (i4 == 3) __builtin_amdgcn_sched_barrier(0);
      }
  }
}

DI void compress_item(KP p, int item, char* smem) {
  const int tid = otid(), lane = tid & 63, w = tid >> 6, fr = lane & 15, fq = lane >> 4;
  const int ct = item & 7, g = (item >> 3) & 1, b = (item >> 4) & 3, kv = item >> 6;
  const u16* W1 = kv ? p->Wt_cv1 : p->Wt_ck1;
  const u16* W2 = kv ? p->Wt_cv2 : p->Wt_ck2;
  const int zc = (kv ? 1280 : 1024) + g * 128;
  const int c = ct * 16 + fr;
  const bool cval = c < 127;
  float* part = (float*)smem;
  u16* h1s = (u16*)(smem + 32768);
  float* red = (float*)(smem + 32768 + 4352);
  f32x4 acc[8];
#pragma unroll
  for (int n = 0; n < 8; ++n) acc[n] = (f32x4){0.f, 0.f, 0.f, 0.f};
  const u16* zb = p->z + (size_t)(b * 2048 + 16 * (cval ? c : 0)) * ZW + zc;
  const u16* w1b = W1 + (size_t)fr * 4096 + w * 1024 + fq * 8;
#pragma unroll 4
  for (int ks = 0; ks < 32; ++ks) {
    const int k = w * 1024 + ks * 32 + fq * 8;
    const int l = k >> 7, d = k & 127;
    u32x4 raw = *(const u32x4*)(zb + (size_t)l * ZW + d);
    if (!cval) raw = (u32x4){0u, 0u, 0u, 0u};
    const bf16x8 a = __builtin_bit_cast(bf16x8, raw);
#pragma unroll
    for (int n = 0; n < 8; ++n) {
      bf16x8 bfr = *(const bf16x8*)(w1b + (size_t)(n * 16) * 4096 + ks * 32);
      acc[n] = MFMA16(a, bfr, acc[n]);
    }
  }
  __syncthreads();
#pragma unroll
  for (int n = 0; n < 8; ++n)
#pragma unroll
    for (int j = 0; j < 4; ++j) part[(w * 16 + fq * 4 + j) * 128 + n * 16 + fr] = acc[n][j];
  __syncthreads();
  {
    const int row = tid >> 4, c0 = (tid & 15) * 8;
#pragma unroll
    for (int e = 0; e < 8; ++e) {
      float v = part[(0 * 16 + row) * 128 + c0 + e] + part[(1 * 16 + row) * 128 + c0 + e] + part[(2 * 16 + row) * 128 + c0 + e] +
                part[(3 * 16 + row) * 128 + c0 + e] + p->cbias[kv * 128 + c0 + e];
      h1s[row * 136 + c0 + e] = (ct * 16 + row < 127) ? f2bf(v * sigm(v)) : (u16)0;
    }
  }
  __syncthreads();
  f32x4 acc2[2];
  acc2[0] = (f32x4){0.f, 0.f, 0.f, 0.f};
  acc2[1] = (f32x4){0.f, 0.f, 0.f, 0.f};
#pragma unroll
  for (int ks = 0; ks < 4; ++ks) {
    bf16x8 a = lds128(h1s + fr * 136 + ks * 32 + fq * 8);
#pragma unroll
    for (int nn = 0; nn < 2; ++nn) {
      bf16x8 bfr = *(const bf16x8*)(W2 + (size_t)((2 * w + nn) * 16 + fr) * 128 + ks * 32 + fq * 8);
      acc2[nn] = MFMA16(a, bfr, acc2[nn]);
    }
  }
  if (kv == 0) {
    float ss[4];
#pragma unroll
    for (int j = 0; j < 4; ++j) {
      ss[j] = acc2[0][j] * acc2[0][j] + acc2[1][j] * acc2[1][j];
      ss[j] += __shfl_xor(ss[j], 1); ss[j] += __shfl_xor(ss[j], 2); ss[j] += __shfl_xor(ss[j], 4); ss[j] += __shfl_xor(ss[j], 8);
    }
    if (fr == 0) {
#pragma unroll
      for (int j = 0; j < 4; ++j) red[w * 16 + fq * 4 + j] = ss[j];
    }
    __syncthreads();
#pragma unroll
    for (int j = 0; j < 4; ++j) {
      const int row = fq * 4 + j;
      float tot = red[row] + red[16 + row] + red[32 + row] + red[48 + row];
      float rs = rsqrtf(tot * (1.f / 128.f) + 1e-6f);
#pragma unroll
      for (int nn = 0; nn < 2; ++nn) {
        const int col = (2 * w + nn) * 16 + fr;
        p->kcmp[((size_t)(b * 2 + g) * 128 + ct * 16 + row) * 128 + col] = f2bf(acc2[nn][j] * rs * p->k_norm_cmp[col]);
      }
    }
  } else {
#pragma unroll
    for (int nn = 0; nn < 2; ++nn) {
      const int col = (2 * w + nn) * 16 + fr;
      uint2 v; v.x = pack2(acc2[nn][0], acc2[nn][1]); v.y = pack2(acc2[nn][2], acc2[nn][3]);
      *(uint2*)(p->vcmpT + ((size_t)(b * 2 + g) * 128 + col) * 128 + ct * 16 + fq * 4) = v;
    }
  }
  __syncthreads();
}

DI void cbias_item(KP p, int item) {
  const int tid = otid(), lane = tid & 63, w = tid >> 6;
  const int o = item * 4 + w;
  const int kv = o >> 7, n = o & 127;
  const u16* W1 = (kv ? p->Wt_cv1 : p->Wt_ck1) + (size_t)n * 4096;
  const float* pos = kv ? p->cmp_pos_v : p->cmp_pos_k;
  float s = 0.f;
#pragma unroll
  for (int i = 0; i < 8; ++i) {
    const int k = (i * 64 + lane) * 8;
    u32x4 wv = *(const u32x4*)(W1 + k);
    float4 p0 = *(const float4*)(pos + k), p1 = *(const float4*)(pos + k + 4);
    s += __uint_as_float(wv[0] << 16) * p0.x + __uint_as_float(wv[0] & 0xffff0000u) * p0.y;
    s += __uint_as_float(wv[1] << 16) * p0.z + __uint_as_float(wv[1] & 0xffff0000u) * p0.w;
    s += __uint_as_float(wv[2] << 16) * p1.x + __uint_as_float(wv[2] & 0xffff0000u) * p1.y;
    s += __uint_as_float(wv[3] << 16) * p1.z + __uint_as_float(wv[3] & 0xffff0000u) * p1.w;
  }
#pragma unroll
  for (int off = 32; off >= 1; off >>= 1) s += __shfl_xor(s, off);
  if (lane == 0) p->cbias[o] = s;
}

DI void conv_item(KP p, int item, char* smem) {
  const int tid = otid();
  const int chunk = item & 7, t0 = ((item >> 3) & 63) * 32, b = item >> 9;
  const int cl = tid & 127, th = tid >> 7;
  const int ch0 = chunk * 128;
  float* hs = (float*)smem;
  __syncthreads();
  {
    const int cq = tid & 31, rg = tid >> 5;
    uint2 ua[8], ub[8];
    const u16* zc = p->z + (size_t)(b * 2048) * ZW + 2584 + ch0 + cq * 4;
#pragma unroll
    for (int i = 0; i < 8; ++i) {
      int tok = t0 - 30 + rg + 8 * i;
      tok = tok < 0 ? 0 : (tok > 2047 ? 2047 : tok);
      ua[i] = *(const uint2*)(zc + (size_t)tok * ZW); ub[i] = *(const uint2*)(zc + (size_t)tok * ZW + 1024);
    }
#pragma unroll
    for (int i = 0; i < 8; ++i) {
      const int row = rg + 8 * i, tok = t0 - 30 + row;
      float4 hv;
      hv.x = __uint_as_float(ua[i].x << 16) * sigm(__uint_as_float(ub[i].x << 16));
      hv.y = __uint_as_float(ua[i].x & 0xffff0000u) * sigm(__uint_as_float(ub[i].x & 0xffff0000u));
      hv.z = __uint_as_float(ua[i].y << 16) * sigm(__uint_as_float(ub[i].y << 16));
      hv.w = __uint_as_float(ua[i].y & 0xffff0000u) * sigm(__uint_as_float(ub[i].y & 0xffff0000u));
      if (tok < 0) hv = make_float4(0.f, 0.f, 0.f, 0.f);
      if (row < 62) *(float4*)(hs + row * 128 + cq * 4) = hv;
    }
  }
  float wv[31];
#pragma unroll
  for (int j = 0; j < 31; ++j) wv[j] = p->conv_w[j * 1024 + ch0 + cl];
  const float bias = p->conv_b[ch0 + cl];
  __syncthreads();
  float y[16];
  {
    float v[46];
#pragma unroll
    for (int i = 0; i < 46; ++i) v[i] = hs[(th * 16 + i) * 128 + cl];
#pragma unroll
    for (int i = 0; i < 16; ++i) y[i] = bias;
#pragma unroll
    for (int j = 0; j < 31; ++j) {
#pragma unroll
      for (int i = 0; i < 16; ++i) y[i] += wv[j] * v[i + j];
    }
  }
  float* yb = p->ybuf + (size_t)(b * 2048 + t0 + th * 16) * 1024 + ch0 + cl;
  __syncthreads();
#pragma unroll
  for (int i = 0; i < 16; ++i) { yb[i * 1024] = y[i]; hs[(th * 16 + i) * 128 + cl] = y[i]; }
  __syncthreads();
  {
    const int tok = tid >> 3, part = tid & 7;
    float a1 = 0.f, a2 = 0.f;
#pragma unroll
    for (int i = 0; i < 16; ++i) { float v = hs[tok * 128 + i * 8 + part]; a1 += v; a2 += v * v; }
    a1 += __shfl_xor(a1, 1); a2 += __shfl_xor(a2, 1);
    a1 += __shfl_xor(a1, 2); a2 += __shfl_xor(a2, 2);
    a1 += __shfl_xor(a1, 4); a2 += __shfl_xor(a2, 4);
    if (part == 0) { atomicAdd(&p->cstats[(size_t)(b * 2048 + t0 + tok) * 2], a1); atomicAdd(&p->cstats[(size_t)(b * 2048 + t0 + tok) * 2 + 1], a2); }
  }
}

DI void conv_fin_item(KP p, int item) {
  const int tid = otid();
  const float4 gg = *(const float4*)(p->conv_ln_g + tid * 4), bt = *(const float4*)(p->conv_ln_b + tid * 4);
#pragma unroll 8
  for (int i = 0; i < 16; ++i) {
    const size_t row = (size_t)item * 16 + i;
    const float mu = p->cstats[row * 2] * (1.f / 1024.f);
    const float var = p->cstats[row * 2 + 1] * (1.f / 1024.f) - mu * mu;
    const float rstd = rsqrtf(fmaxf(var, 0.f) + 1e-5f);
    float4 yv = *(const float4*)(p->ybuf + row * 1024 + tid * 4);
    float a = (yv.x - mu) * rstd * gg.x + bt.x, bq = (yv.y - mu) * rstd * gg.y + bt.y;
    float c = (yv.z - mu) * rstd * gg.z + bt.z, d = (yv.w - mu) * rstd * gg.w + bt.w;
    uint2 o; o.x = pack2(a * sigm(a), bq * sigm(bq)); o.y = pack2(c * sigm(c), d * sigm(d));
    *(uint2*)(p->cat + row * LD2K + 1024 + tid * 4) = o;
  }
}

enum { E_IN = 0, E_MKV = 1, E_RES1 = 2, E_MQ = 3, E_RES2 = 4, E_GU = 5, E_FIN = 6 };

struct GStage { u32x4 a0, a1, a2, a3, b0, b1, b2, b3; };
DI void gemm_gload(GStage& s, const u16* __restrict__ Ag, const u16* __restrict__ Bg, int lda, int ldb, int kt) {
  s.a0 = *(const u32x4*)(Ag + kt * 64);
  s.a1 = *(const u32x4*)(Ag + (size_t)32 * lda + kt * 64);
  s.a2 = *(const u32x4*)(Ag + (size_t)64 * lda + kt * 64);
  s.a3 = *(const u32x4*)(Ag + (size_t)96 * lda + kt * 64);
  s.b0 = *(const u32x4*)(Bg + kt * 64);
  s.b1 = *(const u32x4*)(Bg + (size_t)32 * ldb + kt * 64);
  s.b2 = *(const u32x4*)(Bg + (size_t)64 * ldb + kt * 64);
  s.b3 = *(const u32x4*)(Bg + (size_t)96 * ldb + kt * 64);
}
DI void gemm_lstore(const GStage& s, u16* As, u16* Bs, int lrow, int lsw) {
  u16* a = As + lrow * 64 + lsw;
  u16* b = Bs + lrow * 64 + lsw;
  *(u32x4*)(a) = s.a0; *(u32x4*)(a + 32 * 64) = s.a1; *(u32x4*)(a + 64 * 64) = s.a2; *(u32x4*)(a + 96 * 64) = s.a3;
  *(u32x4*)(b) = s.b0; *(u32x4*)(b + 32 * 64) = s.b1; *(u32x4*)(b + 64 * 64) = s.b2; *(u32x4*)(b + 96 * 64) = s.b3;
}
DI void gemm_rdfrag(bf16x8 (&a)[4], bf16x8 (&bfr)[4], const u16* Ab, const u16* Bb, int rc) {
#pragma unroll
  for (int m = 0; m < 4; ++m) a[m] = lds128(Ab + m * 16 * 64 + rc);
#pragma unroll
  for (int n = 0; n < 4; ++n) bfr[n] = lds128(Bb + n * 16 * 64 + rc);
}
DI void gemm_mma(f32x4 (&acc)[4][4], const bf16x8 (&a)[4], const bf16x8 (&bfr)[4]) {
#pragma unroll
  for (int m = 0; m < 4; ++m)
#pragma unroll
    for (int n = 0; n < 4; ++n) acc[m][n] = MFMA16(a[m], bfr[n], acc[m][n]);
}
#define SB __builtin_amdgcn_sched_barrier(0)

template <int EPI>
DI void gemm_tile(KP p, const u16* __restrict__ A, int lda, const u16* __restrict__ Bt, int ldb, int K, int tm,
                  int tn, char* smem) {
  const int tid = otid(), lane = tid & 63, w = tid >> 6, wr = w >> 1, wc = w & 1, fr = lane & 15, fq = lane >> 4;
  u16* As = (u16*)smem;
  u16* Bs = As + 2 * 128 * 64;
  f32x4 acc[4][4];
#pragma unroll
  for (int m = 0; m < 4; ++m)
#pragma unroll
    for (int n = 0; n < 4; ++n) acc[m][n] = (f32x4){0.f, 0.f, 0.f, 0.f};
  const int lrow = tid >> 3, lkc = (tid & 7) * 8;
  const int lsw = (((tid & 7) ^ ((lrow >> 1) & 7)) * 8);
  const int rc0 = ((fq ^ (fr >> 1)) * 8), rc1 = rc0 ^ 32;
  const u16* Ag = A + (size_t)(tm * 128 + lrow) * lda + lkc;
  const u16* Bg = Bt + (size_t)(tn * 128 + lrow) * ldb + lkc;
  float rsc[4][4];
  if (EPI == E_GU || EPI == E_MQ) {
    const float* rs_src = (EPI == E_GU) ? p->rowss2 : p->rowss1;
#pragma unroll
    for (int m = 0; m < 4; ++m)
#pragma unroll
      for (int j = 0; j < 4; ++j) rsc[m][j] = rs_src[tm * 128 + wr * 64 + m * 16 + fq * 4 + j];
  }
  const int nk = K >> 6;
  const u16* Ab = As + (wr * 64 + fr) * 64;
  const u16* Bb = Bs + (wc * 64 + fr) * 64;
  bf16x8 fa0[4], fb0[4];
  if (false) {
    GStage g0, g1;
    gemm_gload(g0, Ag, Bg, lda, ldb, 0);
    gemm_lstore(g0, As, Bs, lrow, lsw);
    gemm_gload(g0, Ag, Bg, lda, ldb, 1);
    gemm_gload(g1, Ag, Bg, lda, ldb, 2);
    lds_barrier();
    for (int kt = 0; kt < nk; kt += 2) {
      gemm_rdfrag(fa0, fb0, Ab, Bb, rc0);
      SB; gemm_mma(acc, fa0, fb0); SB;
      gemm_rdfrag(fa0, fb0, Ab, Bb, rc1);
      gemm_lstore(g0, As + 128 * 64, Bs + 128 * 64, lrow, lsw);
      if (kt + 3 < nk) gemm_gload(g0, Ag, Bg, lda, ldb, kt + 3);
      SB; gemm_mma(acc, fa0, fb0); SB;
      lds_barrier();
      gemm_rdfrag(fa0, fb0, Ab + 128 * 64, Bb + 128 * 64, rc0);
      SB; gemm_mma(acc, fa0, fb0); SB;
      gemm_rdfrag(fa0, fb0, Ab + 128 * 64, Bb + 128 * 64, rc1);
      if (kt + 2 < nk) gemm_lstore(g1, As, Bs, lrow, lsw);
      if (kt + 4 < nk) gemm_gload(g1, Ag, Bg, lda, ldb, kt + 4);
      SB; gemm_mma(acc, fa0, fb0); SB;
      lds_barrier();
    }
  } else {
    const u16* Agd = A + (size_t)(tm * 128 + lrow) * lda + lsw;
    const u16* Bgd = Bt + (size_t)(tn * 128 + lrow) * ldb + lsw;
#define GDMA(KT, BUF)                                                                                                      \
    _Pragma("unroll") for (int i = 0; i < 4; ++i) {                                                                        \
      __builtin_amdgcn_global_load_lds((const unsigned*)(Agd + (size_t)(32 * i) * lda + (KT) * 64),                        \
                                       (unsigned*)(As + (BUF) * 128 * 64 + tid * 8 + i * 2048), 16, 0, 0);                 \
      __builtin_amdgcn_global_load_lds((const unsigned*)(Bgd + (size_t)(32 * i) * ldb + (KT) * 64),                        \
                                       (unsigned*)(Bs + (BUF) * 128 * 64 + tid * 8 + i * 2048), 16, 0, 0);                 \
    }
    GDMA(0, 0)
    asm volatile("s_waitcnt vmcnt(0)" ::: "memory");
    lds_barrier();
    bf16x8 fa1[4], fb1[4];
#define GHALF(ABUF, BBUF)                                                                         \
      gemm_rdfrag(fa0, fb0, ABUF, BBUF, rc0);                                                     \
      SB;                                                                                         \
      gemm_mma(acc, fa0, fb0); gemm_rdfrag(fa1, fb1, ABUF, BBUF, rc1);                            \
      _Pragma("unroll") for (int q = 0; q < 8; ++q) {                                             \
        __builtin_amdgcn_sched_group_barrier(0x008, 2, 0);                                        \
        __builtin_amdgcn_sched_group_barrier(0x100, 1, 0);                                        \
      }                                                                                           \
      SB;                                                                                         \
      gemm_mma(acc, fa1, fb1);                                                                    \
      SB;
    for (int kt = 0; kt < nk; kt += 2) {
      if (kt + 1 < nk) { GDMA(kt + 1, 1) }
      GHALF(Ab, Bb)
      asm volatile("s_waitcnt vmcnt(0)" ::: "memory");
      lds_barrier();
      if (kt + 2 < nk) { GDMA(kt + 2, 0) }
      GHALF(Ab + 128 * 64, Bb + 128 * 64)
      asm volatile("s_waitcnt vmcnt(0)" ::: "memory");
      lds_barrier();
    }
#undef GHALF
#undef GDMA
  }
  u16* Cs = (u16*)smem;
  float* red = (float*)(smem + 34816);
  if (EPI == E_IN || EPI == E_MKV || EPI == E_MQ) {
    bool donorm = false, transposed = false;
    const float* gain = nullptr;
    u16* dst = nullptr;
    int ldd = 0;
    if (EPI == E_IN) {
      dst = p->z + (size_t)(tm * 128) * ZW + tn * 128; ldd = ZW;
      if (tn < 8) { donorm = true; gain = p->q_norm; }
      else if (tn == 12 || tn == 13) { donorm = true; gain = p->k_norm_slc; }
      else if (tn == 16 || tn == 17) { donorm = true; gain = p->k_norm_win; }
      else if (tn == 14 || tn == 15) { transposed = true; dst = p->vslT + (size_t)(((tm >> 4) * 2 + (tn & 1)) * 128) * 2048 + (tm & 15) * 128; ldd = 2048; }
      else if (tn == 18 || tn == 19) { transposed = true; dst = p->vwT + (size_t)(((tm >> 4) * 2 + (tn & 1)) * 128) * 2048 + (tm & 15) * 128; ldd = 2048; }
    } else if (EPI == E_MKV) {
      if (tn < 4) { donorm = true; gain = p->mk_norm; dst = p->memK + (size_t)(tm * 128) * 512 + tn * 128; ldd = 512; }
      else { transposed = true; dst = p->memVT + (size_t)(((tm >> 1) * 4 + (tn - 4)) * 128) * 256 + (tm & 1) * 128; ldd = 256; }
    } else {
      donorm = true; gain = p->mq_norm;
#pragma unroll
      for (int m = 0; m < 4; ++m)
#pragma unroll
        for (int j = 0; j < 4; ++j) {
          float sr = rsqrtf(rsc[m][j] * (1.f / 2048.f) + 1e-6f);
#pragma unroll
          for (int n = 0; n < 4; ++n) acc[m][n][j] *= sr;
        }
    }
    if (donorm) {
#pragma unroll
      for (int m = 0; m < 4; ++m)
#pragma unroll
        for (int j = 0; j < 4; ++j) {
          float ss = 0.f;
#pragma unroll
          for (int n = 0; n < 4; ++n) ss += acc[m][n][j] * acc[m][n][j];
          ss += __shfl_xor(ss, 1); ss += __shfl_xor(ss, 2); ss += __shfl_xor(ss, 4); ss += __shfl_xor(ss, 8);
          if (fr == 0) red[wc * 128 + wr * 64 + m * 16 + fq * 4 + j] = ss;
        }
      __syncthreads();
#pragma unroll
      for (int m = 0; m < 4; ++m)
#pragma unroll
        for (int j = 0; j < 4; ++j) {
          const int rl = wr * 64 + m * 16 + fq * 4 + j;
          float rs = rsqrtf((red[rl] + red[128 + rl]) * (1.f / 128.f) + 1e-6f);
#pragma unroll
          for (int n = 0; n < 4; ++n) acc[m][n][j] *= rs * gain[wc * 64 + n * 16 + fr];
        }
    }
    if (!transposed) {
#pragma unroll
      for (int m = 0; m < 4; ++m)
#pragma unroll
        for (int n = 0; n < 4; ++n)
#pragma unroll
          for (int j = 0; j < 4; ++j) Cs[(wr * 64 + m * 16 + fq * 4 + j) * 136 + wc * 64 + n * 16 + fr] = f2bf(acc[m][n][j]);
    } else {
#pragma unroll
      for (int m = 0; m < 4; ++m)
#pragma unroll
        for (int n = 0; n < 4; ++n) {
          uint2 v; v.x = pack2(acc[m][n][0], acc[m][n][1]); v.y = pack2(acc[m][n][2], acc[m][n][3]);
          *(uint2*)(Cs + (wc * 64 + n * 16 + fr) * 136 + wr * 64 + m * 16 + fq * 4) = v;
        }
    }
    __syncthreads();
    if (EPI != E_MQ) {
#pragma unroll
      for (int i = 0; i < 8; ++i) {
        int c = tid + 256 * i; int rr = c >> 4, c16 = c & 15;
        *(uint4*)(dst + (size_t)rr * ldd + c16 * 8) = *(const uint4*)(Cs + rr * 136 + c16 * 8);
      }
      __syncthreads();
    }
  } else if (EPI == E_RES1 || EPI == E_RES2) {
    const float* resid = (EPI == E_RES1) ? p->x : p->out;
    float* rowss = (EPI == E_RES1) ? p->rowss1 : p->rowss2;
    float* Cf = (float*)smem;
#pragma unroll
    for (int m = 0; m < 4; ++m)
#pragma unroll
      for (int n = 0; n < 4; ++n)
#pragma unroll
        for (int j = 0; j < 4; ++j) Cf[(wr * 64 + m * 16 + fq * 4 + j) * 132 + wc * 64 + n * 16 + fr] = acc[m][n][j];
    __syncthreads();
#pragma unroll
    for (int i = 0; i < 16; ++i) {
      const int row = (tid >> 5) + 8 * i, c4 = tid & 31;
      const float4 a = *(const float4*)(Cf + row * 132 + c4 * 4);
      const size_t grow = (size_t)(tm * 128 + row);
      const size_t g = grow * 2048 + tn * 128 + c4 * 4;
      const float4 r = *(const float4*)(resid + g);
      float4 v; v.x = r.x + a.x; v.y = r.y + a.y; v.z = r.z + a.z; v.w = r.w + a.w;
      *(float4*)(p->out + g) = v;
      uint2 pk; pk.x = pack2(v.x, v.y); pk.y = pack2(v.z, v.w);
      *(uint2*)(p->actb + grow * LD2K + tn * 128 + c4 * 4) = pk;
      float ss = v.x * v.x + v.y * v.y + v.z * v.z + v.w * v.w;
      ss += __shfl_xor(ss, 1); ss += __shfl_xor(ss, 2); ss += __shfl_xor(ss, 4); ss += __shfl_xor(ss, 8); ss += __shfl_xor(ss, 16);
      if (c4 == 0) atomicAdd(&rowss[grow], ss);
    }
    __syncthreads();
  } else if (EPI == E_GU) {
#pragma unroll
    for (int m = 0; m < 4; ++m)
#pragma unroll
      for (int j = 0; j < 4; ++j) {
        const int rl = wr * 64 + m * 16 + fq * 4 + j;
        float sr = rsqrtf(rsc[m][j] * (1.f / 2048.f) + 1e-6f);
#pragma unroll
        for (int ns = 0; ns < 2; ++ns) {
          float gv = acc[m][ns][j] * sr, uv = acc[m][ns + 2][j] * sr;
          Cs[rl * 72 + wc * 32 + ns * 16 + fr] = f2bf(gv * sigm(gv) * uv);
        }
      }
    __syncthreads();
    u16* dst = p->hidden + (size_t)(tm * 128) * LDH + tn * 64;
#pragma unroll
    for (int i = 0; i < 4; ++i) {
      int c = tid + 256 * i; int rr = c >> 3, c8 = c & 7;
      *(uint4*)(dst + (size_t)rr * LDH + c8 * 8) = *(const uint4*)(Cs + rr * 72 + c8 * 8);
    }
    __syncthreads();
  } else {
    float* Cf = (float*)smem;
#pragma unroll
    for (int m = 0; m < 4; ++m)
#pragma unroll
      for (int n = 0; n < 4; ++n)
#pragma unroll
        for (int j = 0; j < 4; ++j) Cf[(wr * 64 + m * 16 + fq * 4 + j) * 132 + wc * 64 + n * 16 + fr] = acc[m][n][j];
    __syncthreads();
#pragma unroll
    for (int i = 0; i < 16; ++i) {
      const int row = (tid >> 5) + 8 * i, c4 = tid & 31;
      const float4 a = *(const float4*)(Cf + row * 132 + c4 * 4);
      const size_t g = (size_t)(tm * 128 + row) * 2048 + tn * 128 + c4 * 4;
      const float4 r = *(const float4*)(p->out + g);
      float4 v; v.x = r.x + a.x; v.y = r.y + a.y; v.z = r.z + a.z; v.w = r.w + a.w;
      *(float4*)(p->out + g) = v;
    }
    __syncthreads();
  }
}

DI void mem_attn_tile(KP p, int tm, int hd, char* smem) {
  const int tid = otid(), lane = tid & 63, w = tid >> 6, r = lane & 31, h = lane >> 5;
  const u16* Cs = (const u16*)smem;
  bf16x8 qf[8];
#pragma unroll
  for (int ks = 0; ks < 8; ++ks) qf[ks] = lds128(Cs + (w * 32 + r) * 136 + ks * 16 + h * 8);
  u16* Ks = (u16*)smem;
  u16* VTs = Ks + 64 * 136;
  const int b = tm >> 4;
  const u16* kbase = p->memK + (size_t)(b * 256) * 512 + hd * 128;
  const u16* vbase = p->memVT + (size_t)((b * 4 + hd) * 128) * 256;
  f32x16 o[4];
#pragma unroll
  for (int db = 0; db < 4; ++db)
#pragma unroll
    for (int i = 0; i < 16; ++i) o[db][i] = 0.f;
  float m = -1e30f, l = 0.f;
  const float sc = 0.08838834764831845f * 1.44269504089f;
  for (int kb = 0; kb < 4; ++kb) {
    __syncthreads();
    stage_tile64(Ks, VTs, kbase + (size_t)(kb * 64) * 512, 512, vbase + kb * 64, 256);
    __syncthreads();
    flash_tile64<2, false>(o, m, l, qf, nullptr, Ks, VTs, kb * 64, 0, 0.f, sc, true, r, h);
  }
  float lt = l + __shfl_xor(l, 32);
  float f = rcpf_(lt);
  u16* dst = p->omem + (size_t)(tm * 128 + w * 32 + r) * LDO + hd * 128;
#pragma unroll
  for (int db = 0; db < 4; ++db)
#pragma unroll
    for (int i4 = 0; i4 < 4; ++i4) {
      uint2 v; v.x = pack2(o[db][4 * i4] * f, o[db][4 * i4 + 1] * f); v.y = pack2(o[db][4 * i4 + 2] * f, o[db][4 * i4 + 3] * f);
      *(uint2*)(dst + 32 * db + 8 * i4 + 4 * h) = v;
    }
  __syncthreads();
}

#define XB_TMO      128
#define XB_XCNT(j)  (256  + 64 * (j))
#define XB_XSUB(j)  (1280 + 64 * (j))
#define XB_XGEN(j)  (2304 + 64 * (j))
#define XB_TOP      3328
#define XB_TOPGEN   3392
#define XCD_BAR_WORDS 3456
#define XB_SPIN_CAP (1u << 18)
#define LAS __attribute__((address_space(3)))

__device__ __forceinline__ unsigned xb_ld(unsigned* p)              { return __hip_atomic_load(p, __ATOMIC_RELAXED, __HIP_MEMORY_SCOPE_AGENT); }
__device__ __forceinline__ unsigned xb_add(unsigned* p, unsigned v) { return __hip_atomic_fetch_add(p, v, __ATOMIC_RELAXED, __HIP_MEMORY_SCOPE_AGENT); }
__device__ __forceinline__ unsigned xb_xcc_id() { return (unsigned)__builtin_amdgcn_s_getreg((3 << 11) | 20) & 0xFu; }
#define XB_SPIN(cond, bar) do { unsigned _sp = 0; while (cond) { __builtin_amdgcn_s_sleep(1); \
    if ((++_sp & 255u) == 0u) { if (xb_ld(&(bar)[XB_TMO])) break; if (_sp > XB_SPIN_CAP) { atomicAdd(&(bar)[XB_TMO], 1u); break; } } } } while (0)

struct XcdBarrier {
    unsigned* bar; unsigned x;
    volatile LAS unsigned* st;
};

__device__ __forceinline__ XcdBarrier xcd_barrier_post(unsigned* bar, volatile LAS unsigned* st) {
    XcdBarrier b; b.bar = bar; b.x = xb_xcc_id(); b.st = st;
    if (threadIdx.x == 0) (void)xb_add(&bar[XB_XCNT(b.x)], 1u);
    return b;
}
__device__ __forceinline__ void xcd_barrier_complete(unsigned* bar, unsigned x, unsigned& nloc, unsigned& nx) {
    const unsigned G = gridDim.x * gridDim.y * gridDim.z;
    unsigned sum, cnt, mine, sp = 0u;
    for (;;) {
        sum = 0u; cnt = 0u; mine = 0u;
#pragma unroll
        for (unsigned j = 0; j < 16; ++j) { const unsigned c = xb_ld(&bar[XB_XCNT(j)]); sum += c; cnt += (c > 0u) ? 1u : 0u; mine = (j == x) ? c : mine; }
        if (sum == G) break;
        __builtin_amdgcn_s_sleep(1);
        if ((++sp & 255u) == 0u) { if (xb_ld(&bar[XB_TMO])) break; if (sp > XB_SPIN_CAP) { atomicAdd(&bar[XB_TMO], 1u); break; } }
    }
    nloc = mine > 0u ? mine : 1u; nx = cnt > 0u ? cnt : 1u;
}

__device__ __forceinline__ void xcd_barrier(const XcdBarrier& b) {
    asm volatile("s_waitcnt vmcnt(0)" ::: "memory");
    __syncthreads();
    if (threadIdx.x == 0) {
        unsigned* bar = b.bar;
        __builtin_amdgcn_s_waitcnt(0);
        unsigned nloc = b.st[0], nx = b.st[1];
        if (nloc == 0u) { xcd_barrier_complete(bar, b.x, nloc, nx); b.st[0] = nloc; b.st[1] = nx; }
        const unsigned old = xb_add(&bar[XB_XSUB(b.x)], 1u);
        const unsigned gen = old / nloc;
        if (old + 1u == (gen + 1u) * nloc) {
            __builtin_amdgcn_fence(__ATOMIC_RELEASE, "agent");
            asm volatile("s_waitcnt vmcnt(0)" ::: "memory");
            const unsigned og = xb_add(&bar[XB_TOP], 1u);
            const unsigned tg = og / nx;
            if (og + 1u == (tg + 1u) * nx) xb_add(&bar[XB_TOPGEN], 1u);
            else XB_SPIN(xb_ld(&bar[XB_TOPGEN]) == tg, bar);
            __builtin_amdgcn_fence(__ATOMIC_ACQUIRE, "agent");
            xb_add(&bar[XB_XGEN(b.x)], 1u);
            asm volatile("s_waitcnt vmcnt(0)" ::: "memory");
        } else {
            XB_SPIN(xb_ld(&bar[XB_XGEN(b.x)]) == gen, bar);
            __builtin_amdgcn_fence(__ATOMIC_ACQUIRE, "agent");
            asm volatile("s_waitcnt vmcnt(0)" ::: "memory");
        }
    }
    __syncthreads();
}


DI void p1_map(int v, int& tm, int& tn) {
  if (v < 2048) { int sbi = v >> 6, wi = v & 63; tm = (sbi & 7) * 8 + (wi & 7); tn = (sbi >> 3) * 8 + (wi >> 3); }
  else { int u = v - 2048; int grp = u / 40, wi = u - grp * 40; tm = grp * 8 + (wi & 7); tn = 32 + (wi >> 3); }
}
DI bool tile_map(int v, int NSM, int NTN, int& tm, int& tn) {
  int sbi = v >> 6, within = v & 63;
  int sm = within & 7, sn = within >> 3;
  int sbm = sbi % NSM, sbn = sbi / NSM;
  tm = sbm * 8 + sm; tn = sbn * 8 + sn;
  return tn < NTN;
}

__global__ void __launch_bounds__(256, 2) hymba_mega(Params p) {
  extern __shared__ __attribute__((aligned(16))) char smem[];
  cg::grid_group grid = cg::this_grid();
  __shared__ uint4 xb_words;
  if (threadIdx.x == 0) xb_words = make_uint4(0u, 0u, 0u, 0u);
  __syncthreads();
  XcdBarrier xb = xcd_barrier_post(p.bar, (volatile LAS unsigned*)&xb_words);
  const int G = gridDim.x, bid = blockIdx.x;
  const int vb = bid;
  for (int st = 0; st < p.nsteps; ++st) {
    const int ph = (int)((p.steps >> (4 * st)) & 15ull);
    if (st > 0) {
      if (p.use_cg) grid.sync();
      else { XcdBarrier xt = xb; xt.bar = (unsigned*)getp()->bar; xcd_barrier(xt); }
    }
    int tm, tn;
    KP kp = getp();
    switch (ph) {
#if !defined(ONLY) || ONLY == 0
      case 0: phase0(kp, smem); break;
#endif
#if !defined(ONLY) || ONLY == 1
      case 1: {

        for (int v = vb; v < 2368 + 64 + 64; v += G) {
          if (v < 2368) {
            p1_map(v, tm, tn);
            const int nv = v + G; const bool nx = nv < 2368; int tm2 = 0, tn2 = 0; if (nx) p1_map(nv, tm2, tn2);
            (void)nx; (void)tm2; (void)tn2;
            gemm_tile<E_IN>(kp, kp->actb, LD2K, kp->Wt_in, LD2K, 2048, tm, tn, smem);
          } else if (v < 2368 + 64) { int v2 = v - 2368; gemm_tile<E_MKV>(kp, kp->hm, LD2K, kp->Wt_mkv, LD2K, 2048, v2 & 7, v2 >> 3, smem); }
          else cbias_item(kp, v - 2432);
        }
      } break;
#endif
#if !defined(ONLY) || ONLY == 2
      case 2:
        if (G == 512) {
          if (bid < 128) { compress_item(kp, bid, smem); conv_item(kp, bid, smem); }
          else { for (int j = 0; j < 5; ++j) conv_item(kp, 128 + (bid - 128) + 384 * j, smem); }
        } else {
          for (int it = bid; it < 128 + 2048; it += G) { if (it < 2048) conv_item(kp, it, smem); else compress_item(kp, it - 2048, smem); }
        }
        break;
#endif
#if !defined(ONLY) || ONLY == 3
      case 3:
        for (int it = bid; it < 1024; it += G) { if (it < 512) nsa_item(kp, it, smem); else conv_fin_item(kp, it - 512); }
        break;
#endif
#if !defined(ONLY) || ONLY == 4
      case 4: {

        for (int v = vb; v < 1024; v += G) {
          tile_map(v, 8, 16, tm, tn);
          const int nv = v + G; const bool nx = nv < 1024; int tm2 = 0, tn2 = 0; if (nx) tile_map(nv, 8, 16, tm2, tn2);
          gemm_tile<E_RES1>(kp, kp->cat, LD2K, kp->Wt_out, LD2K, 2048, tm, tn, smem);
        }
      } break;
#endif
#if !defined(ONLY) || ONLY == 5
      case 5:
        for (int v = bid; v < 256; v += G) { tm = v & 63; tn = v >> 6; gemm_tile<E_MQ>(kp, kp->actb, LD2K, kp->Wt_mq, LD2K, 2048, tm, tn, smem); mem_attn_tile(kp, tm, tn, smem); }
        break;
#endif
#if !defined(ONLY) || ONLY == 6
      case 6: {

        for (int v = vb; v < 1024; v += G) {
          tile_map(v, 8, 16, tm, tn);
          const int nv = v + G; const bool nx = nv < 1024; int tm2 = 0, tn2 = 0; if (nx) tile_map(nv, 8, 16, tm2, tn2);
          gemm_tile<E_RES2>(kp, kp->omem, LDO, kp->Wt_mo, LDO, 512, tm, tn, smem);
        }
      } break;
#endif
#if !defined(ONLY) || ONLY == 7
      case 7: {

        for (int v = vb; v < 8 * 11 * 64; v += G) {
          tile_map(v, 8, 88, tm, tn);
          const int nv = v + G; const bool nx = nv < 8 * 11 * 64; int tm2 = 0, tn2 = 0; if (nx) tile_map(nv, 8, 88, tm2, tn2);
          gemm_tile<E_GU>(kp, kp->actb, LD2K, kp->Wt_gu, LD2K, 2048, tm, tn, smem);
        }
      } break;
#endif
#if !defined(ONLY) || ONLY == 8
      case 8: {

        for (int v = vb; v < 1024; v += G) {
          tile_map(v, 8, 16, tm, tn);
          const int nv = v + G; const bool nx = nv < 1024; int tm2 = 0, tn2 = 0; if (nx) tile_map(nv, 8, 16, tm2, tn2);
          gemm_tile<E_FIN>(kp, kp->hidden, LDH, kp->Wt_down, LDH, FH, tm, tn, smem);
        }
      } break;
#endif
    }
  }
}

extern "C" void kernel_launch(void* const* d_in, const int* in_sizes, int n_in, void* d_out, int out_size, void* d_ws,
                              size_t ws_size, hipStream_t stream) {
  static int grid_blocks = 0;
  if (!grid_blocks) {
    hipFuncSetAttribute((const void*)hymba_mega, hipFuncAttributeMaxDynamicSharedMemorySize, LDS_BYTES);
    int dev = 0, cus = 0, per_cu = 0;
    hipGetDevice(&dev);
    hipDeviceGetAttribute(&cus, hipDeviceAttributeMultiprocessorCount, dev);
    hipOccupancyMaxActiveBlocksPerMultiprocessor(&per_cu, hymba_mega, 256, LDS_BYTES);
    if (per_cu > 2) per_cu = 2;
    if (per_cu < 1) per_cu = 1;
    grid_blocks = cus * per_cu;
  }
  Params p;
  memset(&p, 0, sizeof(p));
  const float** fp = (const float**)&p;
  for (int i = 0; i < 32; ++i) fp[i] = (const float*)d_in[i];
  p.out = (float*)d_out;
  char* ws = (char*)d_ws;
  size_t off = 0;
  auto take = [&](size_t bytes) { char* r = ws + off; off += (bytes + 255) & ~(size_t)255; return r; };
  p.Wt_in = (u16*)take((size_t)ZW * LD2K * 2);
  p.Wt_mkv = (u16*)take((size_t)1024 * LD2K * 2);
  p.Wt_out = (u16*)take((size_t)2048 * LD2K * 2);
  p.Wt_mq = (u16*)take((size_t)512 * LD2K * 2);
  p.Wt_mo = (u16*)take((size_t)2048 * LDO * 2);
  p.Wt_gu = (u16*)take((size_t)2 * FH * LD2K * 2);
  p.Wt_down = (u16*)take((size_t)2048 * LDH * 2);
  p.Wt_ck1 = (u16*)take((size_t)128 * 4096 * 2);
  p.Wt_cv1 = (u16*)take((size_t)128 * 4096 * 2);
  p.Wt_ck2 = (u16*)take((size_t)128 * 128 * 2);
  p.Wt_cv2 = (u16*)take((size_t)128 * 128 * 2);
  p.actb = (u16*)take((size_t)8192 * LD2K * 2);
  p.ybuf = (float*)p.actb;
  p.hm = (u16*)take((size_t)1024 * LD2K * 2);
  char* region = take((size_t)8192 * ZW * 2 + (size_t)8192 * LD2K * 2);
  p.z = (u16*)region;
  p.cat = (u16*)(region + (size_t)8192 * ZW * 2);
  p.hidden = (u16*)region;
  p.omem = (u16*)take((size_t)8192 * LDO * 2);
  p.memK = (u16*)take((size_t)1024 * 512 * 2);
  p.memVT = (u16*)take((size_t)1024 * 512 * 2);
  p.kcmp = (u16*)take((size_t)8 * 128 * 128 * 2);
  p.vcmpT = (u16*)take((size_t)8 * 128 * 128 * 2);
  p.vslT = (u16*)take((size_t)8 * 128 * 2048 * 2);
  p.vwT = (u16*)take((size_t)8 * 128 * 2048 * 2);
  p.rowss1 = (float*)take(8192 * 4);
  p.rowss2 = (float*)take(8192 * 4);
  p.cstats = (float*)take(8192 * 2 * 4);
  p.bar = (unsigned*)take(XCD_BAR_WORDS * 4);
  p.cbias = (float*)take(256 * 4);
  if (off > ws_size) { fprintf(stderr, "workspace too small: need %zu have %zu\n", off, ws_size); return; }
  hipMemsetAsync(p.bar, 0, XCD_BAR_WORDS * 4, stream);
#if COOP
  p.steps = STEPS; p.nsteps = NSTEPS; p.use_cg = 0;
  void* args[] = {&p};
  hipError_t e = hipLaunchCooperativeKernel((const void*)hymba_mega, dim3(grid_blocks), dim3(256), args, LDS_BYTES, stream);
  if (e != hipSuccess) fprintf(stderr, "cooperative launch failed: %s (grid %d)\n", hipGetErrorString(e), grid_blocks);
#else
  for (int ph = 0; ph < NPHASE; ++ph) {
    p.steps = (unsigned long long)ph; p.nsteps = 1;
    hipLaunchKernelGGL(hymba_mega, dim3(grid_blocks), dim3(256), LDS_BYTES, stream, p);
  }
#endif
}
```
